# Optimizing an MI355X kernel written in HIP

```python
import math
import jax, jax.numpy as jnp
from jax import lax
import numpy as np

D_MODEL = 1024
BATCH = 4
SEQ = 8192
DEPTH = 2

N_EVEN = (DEPTH + 1) // 2
N_ODD = DEPTH // 2

HG_HEADS = 4
HG_DK = 128
HG_DV = 128
HG_WIDTH = HG_HEADS * HG_DK
HG_CHUNK = 32

CV_CH = D_MODEL - HG_HEADS * HG_DV
CV_K = 31

IN_COLS = 4 * HG_WIDTH + 2 * CV_CH

POOL_WINDOWS = (2, 4, 8, 16)
POOL_GROUPS = len(POOL_WINDOWS)
POOL_CH = D_MODEL // POOL_GROUPS

MEM_LEN = 256
XA_HEADS = 4
XA_DH = D_MODEL // XA_HEADS

D_FF = -(-(8 * D_MODEL) // (3 * 256)) * 256

ALPHA = (2 * DEPTH) ** 0.25
BETA = (8 * DEPTH) ** -0.25
LN_EPS = 1e-5
RMS_EPS = 1e-6

kernel_name = "hgrn2_conformer_pool_hybrid_deepnorm"


def layer_norm(x, g, b):
    xf = x.astype(jnp.float32)
    mu = jnp.mean(xf, axis=-1, keepdims=True)
    var = jnp.mean(jnp.square(xf - mu), axis=-1, keepdims=True)
    y = (xf - mu) * lax.rsqrt(var + LN_EPS) * g.astype(jnp.float32) + b.astype(jnp.float32)
    return y.astype(x.dtype)


def hgrn2_chunked(q, k, v, log_f):
    B, S, H, DK = q.shape
    DV = v.shape[-1]
    nc = S // HG_CHUNK

    def to_chunks(t):
        return t.astype(jnp.float32).reshape(B, nc, HG_CHUNK, H, t.shape[-1]).transpose(0, 3, 1, 2, 4)

    q, k, v, log_f = to_chunks(q), to_chunks(k), to_chunks(v), to_chunks(log_f)
    b = jnp.cumsum(log_f, axis=3)
    b_last = b[:, :, :, -1:, :]
    q_t = q * jnp.exp(b)
    k_t = k * jnp.exp(-b)
    causal = jnp.tril(jnp.ones((HG_CHUNK, HG_CHUNK), dtype=bool))
    scores = jnp.einsum('bhntd,bhnsd->bhnts', q_t, k_t)
    scores = jnp.where(causal, scores, 0.0)
    o_intra = jnp.einsum('bhnts,bhnsv->bhntv', scores, v)
    k_end = k * jnp.exp(b_last - b)
    d_state = jnp.einsum('bhnsd,bhnsv->bhndv', k_end, v)
    decay = jnp.exp(b_last[:, :, :, 0, :])

    def step(state, inp):
        dec, ds = inp
        return dec[..., None] * state + ds, state

    s0 = jnp.zeros((B, H, DK, DV), jnp.float32)
    _, s_start = lax.scan(step, s0, (jnp.moveaxis(decay, 2, 0), jnp.moveaxis(d_state, 2, 0)))
    s_start = jnp.moveaxis(s_start, 0, 2)
    o_inter = jnp.einsum('bhntd,bhndv->bhntv', q_t, s_start)
    o = o_intra + o_inter
    return o.transpose(0, 2, 3, 1, 4).reshape(B, S, H, DV)


def hybrid_ab_mixer(x, w_in, lb, hg_norm_g, cv_w, cv_b, cv_ln_g, cv_ln_b, w_out):
    B, S, _ = x.shape
    h = x @ w_in
    q, f_pre, i_v, g, a, a_gate = jnp.split(
        h, [HG_WIDTH, 2 * HG_WIDTH, 3 * HG_WIDTH, 4 * HG_WIDTH, 4 * HG_WIDTH + CV_CH], axis=-1)

    lb = lb.astype(jnp.float32)
    f_pre = f_pre.astype(jnp.float32)
    f = lb + (1.0 - lb) * jax.nn.sigmoid(f_pre)
    k = (1.0 - lb) * jax.nn.sigmoid(-f_pre)
    log_f = jnp.log(f)
    heads = lambda t: t.reshape(B, S, HG_HEADS, -1)
    o = hgrn2_chunked(heads(q), heads(k), heads(i_v), heads(log_f))
    o = o * lax.rsqrt(jnp.mean(jnp.square(o), axis=-1, keepdims=True) + RMS_EPS)
    o = o.reshape(B, S, HG_HEADS * HG_DV) * hg_norm_g.astype(jnp.float32) * jax.nn.silu(g.astype(jnp.float32))

    u = a * jax.nn.sigmoid(a_gate)
    u = lax.conv_general_dilated(
        u, cv_w.astype(u.dtype), window_strides=(1,), padding=[(CV_K - 1, 0)],
        dimension_numbers=('NWC', 'WIO', 'NWC'), feature_group_count=CV_CH) + cv_b
    u = jax.nn.silu(layer_norm(u, cv_ln_g, cv_ln_b))

    y = jnp.concatenate([o.astype(x.dtype), u.astype(x.dtype)], axis=-1)
    return y @ w_out


def multiscale_pool_mixer(x, pool_w, pool_scale):
    B, S, _ = x.shape
    xg = x.astype(jnp.float32).reshape(B, S, POOL_GROUPS, POOL_CH)
    cs = jnp.cumsum(xg, axis=1)
    pos = jnp.arange(1, S + 1, dtype=jnp.float32)
    feats = []
    for gi, w in enumerate(POOL_WINDOWS):
        c = cs[:, :, gi]
        lagged = jnp.pad(c, ((0, 0), (w, 0), (0, 0)))[:, :S]
        mean = (c - lagged) / jnp.minimum(pos, float(w))[:, None]
        feats.append(mean - xg[:, :, gi])
    p = jnp.stack(feats, axis=2).astype(x.dtype)
    y = jnp.einsum('bsgc,gcd->bsgd', p, pool_w).reshape(B, S, D_MODEL)
    return y * pool_scale


def memory_cross_attention(x, mem_n, w_q, w_k, w_v, w_o):
    B, S, _ = x.shape
    q = (x @ w_q).reshape(B, S, XA_HEADS, XA_DH)
    k = (mem_n @ w_k).reshape(B, -1, XA_HEADS, XA_DH)
    v = (mem_n @ w_v).reshape(B, -1, XA_HEADS, XA_DH)
    s = jnp.einsum('bshd,bmhd->bhsm', q, k).astype(jnp.float32) * (XA_DH ** -0.5)
    p = jax.nn.softmax(s, axis=-1).astype(x.dtype)
    o = jnp.einsum('bhsm,bmhd->bshd', p, v).reshape(B, S, D_MODEL)
    return o @ w_o


def swiglu_ffn(x, w_gate, w_up, w_down):
    return (jax.nn.silu(x @ w_gate) * (x @ w_up)) @ w_down


def setup_inputs(seed: int = 0) -> dict:
    key = jax.random.key(seed)
    ks = jax.random.split(key, 32)
    f32 = jnp.float32
    nrm = lambda k, shape, scale: jax.random.normal(k, shape, f32) * scale
    gain = lambda k, shape: 1.0 + 0.02 * jax.random.normal(k, shape, f32)
    bias = lambda k, shape: 0.02 * jax.random.normal(k, shape, f32)
    d = D_MODEL
    return {
        "x": jax.random.normal(ks[0], (BATCH, SEQ, d), f32),
        "mem": jax.random.normal(ks[1], (BATCH, MEM_LEN, d), f32),
        "lb_param": nrm(ks[2], (DEPTH + 1, HG_WIDTH), 0.1),
        "mem_ln_g": gain(ks[3], (d,)),
        "mem_ln_b": bias(ks[4], (d,)),
        "ab_w_in": nrm(ks[5], (N_EVEN, d, IN_COLS), d ** -0.5),
        "hg_norm_g": gain(ks[6], (N_EVEN, HG_HEADS * HG_DV)),
        "cv_w": nrm(ks[7], (N_EVEN, CV_K, 1, CV_CH), CV_K ** -0.5),
        "cv_b": bias(ks[8], (N_EVEN, CV_CH)),
        "cv_ln_g": gain(ks[9], (N_EVEN, CV_CH)),
        "cv_ln_b": bias(ks[10], (N_EVEN, CV_CH)),
        "ab_w_out": nrm(ks[11], (N_EVEN, d, d), BETA * d ** -0.5),
        "pool_w": nrm(ks[12], (N_ODD, POOL_GROUPS, POOL_CH, POOL_CH), BETA * POOL_CH ** -0.5),
        "pool_scale": gain(ks[13], (N_ODD, d)),
        "ln_mix_g": gain(ks[14], (DEPTH, d)),
        "ln_mix_b": bias(ks[15], (DEPTH, d)),
        "xa_wq": nrm(ks[16], (DEPTH, d, d), d ** -0.5),
        "xa_wk": nrm(ks[17], (DEPTH, d, d), d ** -0.5),
        "xa_wv": nrm(ks[18], (DEPTH, d, d), d ** -0.5),
        "xa_wo": nrm(ks[19], (DEPTH, d, d), BETA * d ** -0.5),
        "ln_xa_g": gain(ks[20], (DEPTH, d)),
        "ln_xa_b": bias(ks[21], (DEPTH, d)),
        "ffn_wg": nrm(ks[22], (DEPTH, d, D_FF), d ** -0.5),
        "ffn_wu": nrm(ks[23], (DEPTH, d, D_FF), d ** -0.5),
        "ffn_wd": nrm(ks[24], (DEPTH, D_FF, d), BETA * D_FF ** -0.5),
        "ln_ffn_g": gain(ks[25], (DEPTH, d)),
        "ln_ffn_b": bias(ks[26], (DEPTH, d)),
    }


def reference(x, mem, lb_param, mem_ln_g, mem_ln_b, ab_w_in, hg_norm_g, cv_w, cv_b,
              cv_ln_g, cv_ln_b, ab_w_out, pool_w, pool_scale, ln_mix_g, ln_mix_b,
              xa_wq, xa_wk, xa_wv, xa_wo, ln_xa_g, ln_xa_b, ffn_wg, ffn_wu, ffn_wd,
              ln_ffn_g, ln_ffn_b):
    lb_all = jnp.cumsum(jax.nn.softmax(lb_param.astype(jnp.float32), axis=0), axis=0)
    mem_n = layer_norm(mem, mem_ln_g, mem_ln_b)
    for l in range(DEPTH):
        if l % 2 == 0:
            e = l // 2
            y = hybrid_ab_mixer(x, ab_w_in[e], lb_all[l], hg_norm_g[e], cv_w[e], cv_b[e],
                                cv_ln_g[e], cv_ln_b[e], ab_w_out[e])
        else:
            o = l // 2
            y = multiscale_pool_mixer(x, pool_w[o], pool_scale[o])
        x = layer_norm(ALPHA * x + y, ln_mix_g[l], ln_mix_b[l])
        y = memory_cross_attention(x, mem_n, xa_wq[l], xa_wk[l], xa_wv[l], xa_wo[l])
        x = layer_norm(ALPHA * x + y, ln_xa_g[l], ln_xa_b[l])
        y = swiglu_ffn(x, ffn_wg[l], ffn_wu[l], ffn_wd[l])
        x = layer_norm(ALPHA * x + y, ln_ffn_g[l], ln_ffn_b[l])
    return x
```

```cpp
#include <hip/hip_runtime.h>
#include <hip/hip_cooperative_groups.h>
#include <cstdio>
#include <cstdint>
namespace cg = cooperative_groups;

#define LAS __attribute__((address_space(3)))
typedef unsigned short bf16_t;
typedef short bf16x8 __attribute__((ext_vector_type(8)));
typedef float f32x4 __attribute__((ext_vector_type(4)));
typedef float f32x2 __attribute__((ext_vector_type(2)));
typedef unsigned u32x4 __attribute__((ext_vector_type(4)));
typedef unsigned u32x2 __attribute__((ext_vector_type(2)));

#define LDS_WAIT() asm volatile("s_waitcnt lgkmcnt(0)" ::: "memory")
#define VM_WAIT() asm volatile("s_waitcnt vmcnt(0)" ::: "memory")

constexpr int DM = 1024, NBATCH = 4, SEQ = 8192, MROWS = NBATCH * SEQ, MEMLEN = 256, MEMROWS = NBATCH * MEMLEN, FF = 2816, INCOLS = 3072;
constexpr int HBW = 2560;
constexpr float ALPHA = 1.4142135623730951f;
constexpr float LN_EPS = 1e-5f, RMS_EPS = 1e-6f;

constexpr size_t MiB = (size_t)1 << 20;
constexpr size_t WS_WIN = 0 * MiB, WS_WOUT = 6 * MiB, WS_WQ = 8 * MiB, WS_WK = 12 * MiB, WS_WV = 16 * MiB, WS_WO = 20 * MiB, WS_WGU = 24 * MiB, WS_WD = 46 * MiB,
                 WS_WPOOL = 57 * MiB, WS_MEMN = 58 * MiB, WS_KMAT = 60 * MiB, WS_VT = 64 * MiB, WS_LBV = 68 * MiB, WS_BAR = 68 * MiB + 65536, WS_SDEC = 69 * MiB, WS_SLOC = 70 * MiB,
                 WS_XB = 88 * MiB, WS_R3 = 152 * MiB, WS_LF = 216 * MiB, WS_R1 = 280 * MiB, WS_SST = 456 * MiB, WS_ABT = 472 * MiB, WS_CBT = 488 * MiB, WS_END = 504 * MiB;
constexpr int RING_BYTES = 131072, XCH_OFF = RING_BYTES, LDS_BYTES = RING_BYTES + 8192 + 1024;

struct Args { const float* in[27]; float* out; unsigned char* ws; };

typedef const __attribute__((address_space(4))) Args* CArgs;
__device__ __forceinline__ CArgs get_args() { CArgs p = (CArgs)__builtin_amdgcn_kernarg_segment_ptr(); asm volatile("" : "+s"(p)); return p; }
#define AIN(i) ((const float*)get_args()->in[i])
#define WSP(off) ((unsigned char*)get_args()->ws + (off))


__device__ __forceinline__ int lane_id_v() { int l; asm volatile("v_mbcnt_lo_u32_b32 %0, -1, 0\n\tv_mbcnt_hi_u32_b32 %0, -1, %0" : "=v"(l)); return l; }
typedef __bf16 bf16x2_t __attribute__((ext_vector_type(2)));
__device__ __forceinline__ unsigned cvt_pk_bf16(float lo, float hi) { f32x2 f = {lo, hi}; bf16x2_t v = __builtin_convertvector(f, bf16x2_t); return __builtin_bit_cast(unsigned, v); }
__device__ __forceinline__ float bf2f(unsigned short v) { return __uint_as_float(((unsigned)v) << 16); }
__device__ __forceinline__ float bflo(unsigned v) { return __uint_as_float(v << 16); }
__device__ __forceinline__ float bfhi(unsigned v) { return __uint_as_float(v & 0xffff0000u); }
__device__ __forceinline__ float sigmoidf_(float x) { return __builtin_amdgcn_rcpf(1.0f + __expf(-x)); }
__device__ __forceinline__ float siluf_(float x) { return x * sigmoidf_(x); }
__device__ __forceinline__ float wave_sum(float v) {
#pragma unroll
    for (int o = 1; o < 64; o <<= 1) v += __shfl_xor(v, o);
    return v;
}

namespace pg8 {
constexpr int BM = 256, BK = 64, HALF = 128, HTB = HALF * BK * 2, NXCD = 8, WGM = 8;
__device__ __forceinline__ int lds_byte(int r, int c) { const int st = (r >> 4) * 2 + (c >> 5), rr = r & 15, cc = c & 31, ob = rr * 64 + cc * 2; return st * 1024 + (ob ^ (((ob >> 9) & 1) << 5)); }
__device__ __forceinline__ void stage_rc(int b, int& R, int& C) { const int st = b / 1024, sb = b % 1024, swz = sb ^ (((sb >> 9) & 1) << 5); R = (st >> 1) * 16 + swz / 64; C = (st & 1) * 32 + (swz % 64) / 2; }
__device__ __forceinline__ int perm32(int rho) { const int n = rho >> 4, i = rho & 15; return 8 * (i >> 2) + 4 * n + (i & 3); }

struct Unit { int pm, pn; };
struct Gemm { const bf16_t* A; const bf16_t* Bt; int lda, ldb, K; long a_pn_off; int a_sh, a_mask; long a_hi, a_lo; long b_pn_off; int b_sh, b_mask; long b_hi, b_lo; };
__device__ __forceinline__ Gemm mk_gemm(const bf16_t* A, const bf16_t* Bt, int lda, int ldb, int K) { Gemm g; g.A = A; g.Bt = Bt; g.lda = lda; g.ldb = ldb; g.K = K;
    g.a_pn_off = 0; g.a_sh = 0; g.a_mask = 0; g.a_hi = (long)BM * lda; g.a_lo = 0; g.b_pn_off = (long)BM * ldb; g.b_sh = 0; g.b_mask = 0; g.b_hi = 0; g.b_lo = 0; return g; }
__device__ __forceinline__ const char* unitA(const Gemm& g, const Unit& u) { return (const char*)(g.A + (size_t)(u.pm >> g.a_sh) * g.a_hi + (size_t)(u.pm & g.a_mask) * g.a_lo + (size_t)u.pn * g.a_pn_off); }
__device__ __forceinline__ const char* unitB(const Gemm& g, const Unit& u) { return (const char*)(g.Bt + (size_t)u.pn * g.b_pn_off + (size_t)(u.pm >> g.b_sh) * g.b_hi + (size_t)(u.pm & g.b_mask) * g.b_lo); }

struct Order {
    int nM, nN, nwg, G, c;
    __device__ void init(int nM_, int nN_, int G_, int c_) { nM = nM_; nN = nN_; nwg = nM * nN; G = G_; c = c_; }
    __device__ bool next(int i, Unit& u) const {
        const long L = (long)i * G + c; if (L >= nwg) return false;
        int wgid = (int)L; { const int q = nwg / NXCD, r = nwg % NXCD, xcd = wgid % NXCD, off = wgid / NXCD; wgid = (xcd < r ? xcd * (q + 1) : r * (q + 1) + (xcd - r) * q) + off; }
        const int nig = WGM * nN, gid = wgid / nig, fm = gid * WGM, gsz = (nM - fm) < WGM ? (nM - fm) : WGM;
        u.pm = fm + ((wgid % nig) % gsz); u.pn = (wgid % nig) / gsz; return true;
    }
};

template <class Epi>
__device__ __forceinline__ void gemm_phase(LAS unsigned char* lds, const Gemm g, const Order& S, const Epi& E, const int wid) {
    const int lane = lane_id_v(), tid = wid * 64 + lane;
    const int wr = wid >> 2, wc = wid & 3, fr = lane & 15, fq = lane >> 4;
    const int nt = g.K / BK;
    unsigned voffA[2], voffB[2];
#pragma unroll
    for (int i = 0; i < 2; ++i) { int R, C; stage_rc(tid * 16 + i * 8192, R, C); const int Rb = Epi::PERM ? ((R & ~31) + perm32(R & 31)) : R;
        voffA[i] = (unsigned)(R * g.lda + C) * 2u; voffB[i] = (unsigned)(Rb * g.ldb + C) * 2u; }
    const size_t kstep = (size_t)(BK * 2);
    const size_t hstepA = (size_t)HALF * g.lda * 2, hstepB = (size_t)HALF * g.ldb * 2;
    const unsigned ldsw = (unsigned)wid * 1024u;
    const int aoff = lds_byte(wr * 64 + fr, fq * 8), boff = lds_byte(wc * 32 + fr, fq * 8);
#define PG8_SA(b, h) (((b) * 2 + (h)) * HTB)
#define PG8_SB(b, h) ((4 + (b) * 2 + (h)) * HTB)
#define PG8_STAGE(bufoff, gbase, voff) do { _Pragma("unroll") for (int _i = 0; _i < 2; ++_i) \
        __builtin_amdgcn_global_load_lds((const unsigned*)((const char*)(gbase) + (voff)[_i]), (LAS unsigned*)(lds + (bufoff) + ldsw + _i * 8192), 16, 0, 0); } while (0)
#define PG8_LDA(dst, b, h) do { _Pragma("unroll") for (int m = 0; m < 4; ++m) _Pragma("unroll") for (int k = 0; k < 2; ++k) dst[m][k] = *(const LAS bf16x8*)(lds + PG8_SA(b, h) + aoff + m * 2048 + k * 1024); } while (0)
#define PG8_LDB(dst, b, h) do { _Pragma("unroll") for (int n = 0; n < 2; ++n) _Pragma("unroll") for (int k = 0; k < 2; ++k) dst[n][k] = *(const LAS bf16x8*)(lds + PG8_SB(b, h) + boff + n * 2048 + k * 1024); } while (0)
#define PG8_MMA(ai, bj, At, Bt) do { __builtin_amdgcn_s_setprio(1); _Pragma("unroll") for (int m = 0; m < 4; ++m) _Pragma("unroll") for (int n = 0; n < 2; ++n) _Pragma("unroll") for (int k = 0; k < 2; ++k) \
        acc[ai][bj][m][n] = __builtin_amdgcn_mfma_f32_16x16x32_bf16(Bt[n][k], At[m][k], acc[ai][bj][m][n], 0, 0, 0); __builtin_amdgcn_s_setprio(0); } while (0)
#define PG8_WAIT_V(n) asm volatile("s_waitcnt vmcnt(" #n ")" ::: "memory")
#define PG8_WAIT_L(n) asm volatile("s_waitcnt lgkmcnt(" #n ")" ::: "memory")
#define PG8_BAR __builtin_amdgcn_s_barrier()
#define PG8_SCHED __builtin_amdgcn_sched_barrier(0)
    Unit cur, nxt; int ui = 0;
    if (!S.next(0, cur)) return;
    f32x4 acc[2][2][4][2];
#pragma unroll
    for (int a = 0; a < 2; ++a)
#pragma unroll
        for (int b = 0; b < 2; ++b)
#pragma unroll
            for (int m = 0; m < 4; ++m)
#pragma unroll
                for (int n = 0; n < 2; ++n) acc[a][b][m][n] = (f32x4){0.f, 0.f, 0.f, 0.f};
    bf16x8 At[4][2], B0[2][2], B1[2][2];
    const char* cA = unitA(g, cur); const char* cB = unitB(g, cur);
    PG8_STAGE(PG8_SB(0, 0), cB, voffB); PG8_STAGE(PG8_SB(0, 1), cB + hstepB, voffB); PG8_STAGE(PG8_SA(0, 0), cA, voffA); PG8_STAGE(PG8_SA(0, 1), cA + hstepA, voffA);
    if (wr == 1) PG8_BAR;
    PG8_WAIT_V(2); PG8_BAR;
    PG8_STAGE(PG8_SB(1, 0), cB + kstep, voffB); PG8_STAGE(PG8_SA(1, 0), cA + kstep, voffA); PG8_STAGE(PG8_SB(1, 1), cB + hstepB + kstep, voffB);
    PG8_WAIT_V(6); PG8_BAR;
    for (;;) {
        const bool has_next = S.next(ui + 1, nxt);
        const char* nA = has_next ? unitA(g, nxt) : cA; const char* nB = has_next ? unitB(g, nxt) : cB;
        for (int t = 0; t < nt; t += 2) {
            const bool last = (t == nt - 2);
            const char* a1 = cA + (size_t)(t + 1) * kstep;
            const char* a2 = last ? nA : cA + (size_t)(t + 2) * kstep; const char* b2 = last ? nB : cB + (size_t)(t + 2) * kstep;
            const char* a3 = a2 + kstep; const char* b3 = b2 + kstep;
            PG8_LDB(B0, 0, 0); PG8_LDB(B1, 0, 1); PG8_SCHED; PG8_LDA(At, 0, 0); PG8_STAGE(PG8_SA(1, 1), a1 + hstepA, voffA);
            PG8_WAIT_V(8); PG8_WAIT_L(0); PG8_BAR; PG8_MMA(0, 0, At, B0); PG8_MMA(0, 1, At, B1); PG8_BAR; PG8_SCHED;
            PG8_LDA(At, 0, 1); PG8_STAGE(PG8_SB(0, 0), b2, voffB); PG8_STAGE(PG8_SB(0, 1), b2 + hstepB, voffB); PG8_STAGE(PG8_SA(0, 0), a2, voffA);
            PG8_WAIT_V(8); PG8_WAIT_L(0); PG8_BAR; PG8_MMA(1, 0, At, B0); PG8_MMA(1, 1, At, B1); PG8_BAR; PG8_SCHED;
            PG8_LDB(B0, 1, 0); PG8_LDB(B1, 1, 1); PG8_SCHED; PG8_LDA(At, 1, 0); PG8_STAGE(PG8_SA(0, 1), a2 + hstepA, voffA);
            PG8_WAIT_V(8); PG8_WAIT_L(0); PG8_BAR; PG8_MMA(0, 0, At, B0); PG8_MMA(0, 1, At, B1); PG8_BAR; PG8_SCHED;
            PG8_LDA(At, 1, 1); PG8_STAGE(PG8_SB(1, 0), b3, voffB); PG8_STAGE(PG8_SB(1, 1), b3 + hstepB, voffB); PG8_STAGE(PG8_SA(1, 0), a3, voffA);
            PG8_WAIT_V(8); PG8_WAIT_L(0); PG8_BAR; PG8_MMA(1, 0, At, B0); PG8_MMA(1, 1, At, B1); PG8_BAR; PG8_SCHED;
        }
        if (wr == 0) PG8_BAR;
        { int fr_ = fr, fq_ = fq; asm volatile("" : "+v"(fr_), "+v"(fq_));
          E(acc, cur, wr, wc, fr_, fq_); }
        if (!has_next) break;
#pragma unroll
        for (int a = 0; a < 2; ++a)
#pragma unroll
            for (int b = 0; b < 2; ++b)
#pragma unroll
                for (int m = 0; m < 4; ++m)
#pragma unroll
                    for (int n = 0; n < 2; ++n) acc[a][b][m][n] = (f32x4){0.f, 0.f, 0.f, 0.f};
        cur = nxt; cA = nA; cB = nB; ++ui;
        if (wr == 1) PG8_BAR;
    }
    PG8_WAIT_V(0);
    PG8_BAR;
#undef PG8_SA
#undef PG8_SB
#undef PG8_STAGE
#undef PG8_LDA
#undef PG8_LDB
#undef PG8_MMA
#undef PG8_WAIT_V
#undef PG8_WAIT_L
#undef PG8_BAR
#undef PG8_SCHED
}

typedef const f32x4 (&AccRef)[2][2][4][2];

struct EpiStoreBf16 {
    static constexpr bool PERM = true;
    bf16_t* O; int ldc; float scale; const float* colscale;
    __device__ __forceinline__ void operator()(AccRef acc, const Unit& u, int wr, int wc, int fr, int fq) const {
        const int row0 = u.pm * BM + wr * 64 + fr, col0 = u.pn * BM + wc * 32 + 8 * fq;
        f32x4 cs[2][2];
#pragma unroll
        for (int bj = 0; bj < 2; ++bj)
#pragma unroll
            for (int n = 0; n < 2; ++n) { cs[bj][n] = colscale ? *(const f32x4*)(colscale + col0 + bj * HALF + 4 * n) : (f32x4){1.f, 1.f, 1.f, 1.f}; cs[bj][n] = cs[bj][n] * scale; }
#pragma unroll
        for (int ai = 0; ai < 2; ++ai)
#pragma unroll
            for (int m = 0; m < 4; ++m) { bf16_t* rowp = O + (size_t)(row0 + ai * HALF + m * 16) * ldc + col0;
#pragma unroll
                for (int bj = 0; bj < 2; ++bj) { const f32x4 v0 = acc[ai][bj][m][0] * cs[bj][0], v1 = acc[ai][bj][m][1] * cs[bj][1];
                    u32x4 w; w.x = cvt_pk_bf16(v0[0], v0[1]); w.y = cvt_pk_bf16(v0[2], v0[3]); w.z = cvt_pk_bf16(v1[0], v1[1]); w.w = cvt_pk_bf16(v1[2], v1[3]);
                    __builtin_nontemporal_store(w, (u32x4*)(rowp + bj * HALF)); } }
    }
};

struct EpiWin {
    static constexpr bool PERM = true;
    bf16_t* Hb; float* LF; const float* lbv;
    __device__ __forceinline__ void operator()(AccRef acc, const Unit& u, int wr, int wc, int fr, int fq) const {
        const int row0 = u.pm * BM + wr * 64 + fr, cw = wc * 32 + 8 * fq, pn = u.pn;
        if (pn >= 8) {
#pragma unroll
            for (int ai = 0; ai < 2; ++ai)
#pragma unroll
                for (int m = 0; m < 4; ++m) { bf16_t* rowp = Hb + (size_t)(row0 + ai * HALF + m * 16) * HBW + 2048 + (pn - 8) * 128 + cw;
                    f32x4 r0, r1;
#pragma unroll
                    for (int e = 0; e < 4; ++e) { r0[e] = acc[ai][0][m][0][e] * sigmoidf_(acc[ai][1][m][0][e]); r1[e] = acc[ai][0][m][1][e] * sigmoidf_(acc[ai][1][m][1][e]); }
                    u32x4 w; w.x = cvt_pk_bf16(r0[0], r0[1]); w.y = cvt_pk_bf16(r0[2], r0[3]); w.z = cvt_pk_bf16(r1[0], r1[1]); w.w = cvt_pk_bf16(r1[2], r1[3]);
                    *(u32x4*)rowp = w; }
        } else if (pn == 2 || pn == 3) {
#pragma unroll
            for (int bj = 0; bj < 2; ++bj) { const int j0 = (pn - 2) * 256 + bj * HALF + cw;
                const f32x4 lb0 = *(const f32x4*)(lbv + j0), lb1 = *(const f32x4*)(lbv + j0 + 4);
#pragma unroll
                for (int ai = 0; ai < 2; ++ai)
#pragma unroll
                    for (int m = 0; m < 4; ++m) { const size_t row = (size_t)(row0 + ai * HALF + m * 16);
                        f32x4 l0, l1, k0, k1;
#pragma unroll
                        for (int e = 0; e < 4; ++e) {
                            { float x = acc[ai][bj][m][0][e]; x = fminf(fmaxf(x, -30.f), 30.f); const float ex = __expf(-x), rc = __builtin_amdgcn_rcpf(1.0f + ex), lb = lb0[e];
                              l0[e] = __logf(lb + (1.0f - lb) * rc); k0[e] = (1.0f - lb) * ex * rc; }
                            { float x = acc[ai][bj][m][1][e]; x = fminf(fmaxf(x, -30.f), 30.f); const float ex = __expf(-x), rc = __builtin_amdgcn_rcpf(1.0f + ex), lb = lb1[e];
                              l1[e] = __logf(lb + (1.0f - lb) * rc); k1[e] = (1.0f - lb) * ex * rc; } }
                        *(f32x4*)(LF + row * 512 + j0) = l0; *(f32x4*)(LF + row * 512 + j0 + 4) = l1;
                        u32x4 w; w.x = cvt_pk_bf16(k0[0], k0[1]); w.y = cvt_pk_bf16(k0[2], k0[3]); w.z = cvt_pk_bf16(k1[0], k1[1]); w.w = cvt_pk_bf16(k1[2], k1[3]);
                        *(u32x4*)(Hb + row * HBW + 512 + j0) = w; } }
        } else {
            const bool act = pn >= 6;
#pragma unroll
            for (int ai = 0; ai < 2; ++ai)
#pragma unroll
                for (int m = 0; m < 4; ++m) { bf16_t* rowp = Hb + (size_t)(row0 + ai * HALF + m * 16) * HBW + pn * 256 + cw;
#pragma unroll
                    for (int bj = 0; bj < 2; ++bj) { f32x4 v0 = acc[ai][bj][m][0], v1 = acc[ai][bj][m][1];
                        if (act) {
#pragma unroll
                            for (int e = 0; e < 4; ++e) { v0[e] = siluf_(v0[e]); v1[e] = siluf_(v1[e]); } }
                        u32x4 w; w.x = cvt_pk_bf16(v0[0], v0[1]); w.y = cvt_pk_bf16(v0[2], v0[3]); w.z = cvt_pk_bf16(v1[0], v1[1]); w.w = cvt_pk_bf16(v1[2], v1[3]);
                        *(u32x4*)(rowp + bj * HALF) = w; } }
        }
    }
};

struct EpiSwiGLU {
    static constexpr bool PERM = true;
    bf16_t* H; int ldc;
    __device__ __forceinline__ void operator()(AccRef acc, const Unit& u, int wr, int wc, int fr, int fq) const {
        const int row0 = u.pm * BM + wr * 64 + fr, col0 = u.pn * HALF + wc * 32 + 8 * fq;
#pragma unroll
        for (int ai = 0; ai < 2; ++ai)
#pragma unroll
            for (int m = 0; m < 4; ++m) { bf16_t* rowp = H + (size_t)(row0 + ai * HALF + m * 16) * ldc + col0;
                f32x4 r0, r1;
#pragma unroll
                for (int e = 0; e < 4; ++e) { r0[e] = siluf_(acc[ai][0][m][0][e]) * acc[ai][1][m][0][e]; r1[e] = siluf_(acc[ai][0][m][1][e]) * acc[ai][1][m][1][e]; }
                u32x4 w; w.x = cvt_pk_bf16(r0[0], r0[1]); w.y = cvt_pk_bf16(r0[2], r0[3]); w.z = cvt_pk_bf16(r1[0], r1[1]); w.w = cvt_pk_bf16(r1[2], r1[3]);
                *(u32x4*)rowp = w; }
    }
};

struct EpiSoftmax {
    static constexpr bool PERM = true;
    LAS float* X;
    __device__ __forceinline__ void operator()(AccRef acc, const Unit& u, int wr, int wc, int fr, int fq) const {
#pragma unroll
        for (int ai = 0; ai < 2; ++ai)
#pragma unroll
            for (int m = 0; m < 4; ++m) {
                float mx = -3.0e38f;
#pragma unroll
                for (int bj = 0; bj < 2; ++bj)
#pragma unroll
                    for (int n = 0; n < 2; ++n) { const f32x4 v = acc[ai][bj][m][n]; mx = fmaxf(mx, fmaxf(fmaxf(v[0], v[1]), fmaxf(v[2], v[3]))); }
                mx = fmaxf(mx, __shfl_xor(mx, 16)); mx = fmaxf(mx, __shfl_xor(mx, 32));
                float s = 0.f;
#pragma unroll
                for (int bj = 0; bj < 2; ++bj)
#pragma unroll
                    for (int n = 0; n < 2; ++n) { const f32x4 v = acc[ai][bj][m][n]; s += (__expf(v[0] - mx) + __expf(v[1] - mx)) + (__expf(v[2] - mx) + __expf(v[3] - mx)); }
                s += __shfl_xor(s, 16); s += __shfl_xor(s, 32);
                if (fq == 0) *(LAS f32x2*)(X + (ai * HALF + wr * 64 + m * 16 + fr) * 8 + wc * 2) = (f32x2){mx, s};
                __builtin_amdgcn_sched_barrier(0);
            }
        LDS_WAIT(); __builtin_amdgcn_s_barrier(); asm volatile("" ::: "memory");
        const int col0 = u.pn * BM + wc * 32 + 8 * fq;
#pragma unroll
        for (int ai = 0; ai < 2; ++ai)
#pragma unroll
            for (int m = 0; m < 4; ++m) { const int r = ai * HALF + wr * 64 + m * 16 + fr;
                const f32x4 a = *(const LAS f32x4*)(X + r * 8), b = *(const LAS f32x4*)(X + r * 8 + 4);
                const float M = fmaxf(fmaxf(a[0], a[2]), fmaxf(b[0], b[2]));
                const float ssum = (a[1] * __expf(a[0] - M) + a[3] * __expf(a[2] - M)) + (b[1] * __expf(b[0] - M) + b[3] * __expf(b[2] - M));
                const float inv = __builtin_amdgcn_rcpf(ssum);
                bf16_t* rowp = ((bf16_t*)WSP(WS_R1) + (size_t)MROWS * DM) + (size_t)(u.pm * BM + r) * DM + col0;
#pragma unroll
                for (int bj = 0; bj < 2; ++bj) { f32x4 v0 = acc[ai][bj][m][0], v1 = acc[ai][bj][m][1];
#pragma unroll
                    for (int e = 0; e < 4; ++e) { v0[e] = __expf(v0[e] - M) * inv; v1[e] = __expf(v1[e] - M) * inv; }
                    u32x4 w; w.x = cvt_pk_bf16(v0[0], v0[1]); w.y = cvt_pk_bf16(v0[2], v0[3]); w.z = cvt_pk_bf16(v1[0], v1[1]); w.w = cvt_pk_bf16(v1[2], v1[3]);
                    *(u32x4*)(rowp + bj * HALF) = w; }
                __builtin_amdgcn_sched_barrier(0); }
    }
};
}


#define XB_TMO      128
#define XB_XCNT(j)  (256  + 64 * (j))
#define XB_XSUB(j)  (1280 + 64 * (j))
#define XB_XGEN(j)  (2304 + 64 * (j))
#define XB_TOP      3328
#define XB_TOPGEN   3392
#define XCD_BAR_WORDS 3456
#define XB_SPIN_CAP (1u << 18)
__device__ __forceinline__ unsigned xb_ld(unsigned* p)              { return __hip_atomic_load(p, __ATOMIC_RELAXED, __HIP_MEMORY_SCOPE_AGENT); }
__device__ __forceinline__ unsigned xb_add(unsigned* p, unsigned v) { return __hip_atomic_fetch_add(p, v, __ATOMIC_RELAXED, __HIP_MEMORY_SCOPE_AGENT); }
__device__ __forceinline__ unsigned xb_xcc_id() { return (unsigned)__builtin_amdgcn_s_getreg((3 << 11) | 20) & 0xFu; }
#define XB_SPIN(cond, bar) do { unsigned _sp = 0; while (cond) { __builtin_amdgcn_s_sleep(1); \
    if ((++_sp & 255u) == 0u) { if (xb_ld(&(bar)[XB_TMO])) break; if (_sp > XB_SPIN_CAP) { atomicAdd(&(bar)[XB_TMO], 1u); break; } } } } while (0)
struct XcdBarrier { unsigned* bar; unsigned x; volatile LAS unsigned* st; };
__device__ __forceinline__ XcdBarrier xcd_barrier_post(unsigned* bar, volatile LAS unsigned* st) {
    XcdBarrier b; b.bar = bar; b.x = xb_xcc_id(); b.st = st;
    if (threadIdx.x == 0) (void)xb_add(&bar[XB_XCNT(b.x)], 1u);
    return b;
}
__device__ __forceinline__ void xcd_barrier_complete(unsigned* bar, unsigned x, unsigned& nloc, unsigned& nx) {
    const unsigned G = gridDim.x * gridDim.y * gridDim.z;
    unsigned sum, cnt, mine, sp = 0u;
    for (;;) {
        sum = 0u; cnt = 0u; mine = 0u;
#pragma unroll
        for (unsigned j = 0; j < 16; ++j) { const unsigned c = xb_ld(&bar[XB_XCNT(j)]); sum += c; cnt += (c > 0u) ? 1u : 0u; mine = (j == x) ? c : mine; }
        if (sum == G) break;
        __builtin_amdgcn_s_sleep(1);
        if ((++sp & 255u) == 0u) { if (xb_ld(&bar[XB_TMO])) break; if (sp > XB_SPIN_CAP) { atomicAdd(&bar[XB_TMO], 1u); break; } }
    }
    nloc = mine > 0u ? mine : 1u; nx = cnt > 0u ? cnt : 1u;
}
__device__ __forceinline__ void xcd_barrier(const XcdBarrier& b) {
    asm volatile("s_waitcnt vmcnt(0)" ::: "memory");
    __syncthreads();
    if (threadIdx.x == 0) {
        unsigned* bar = b.bar;
        __builtin_amdgcn_s_waitcnt(0);
        unsigned nloc = b.st[0], nx = b.st[1];
        if (nloc == 0u) { xcd_barrier_complete(bar, b.x, nloc, nx); b.st[0] = nloc; b.st[1] = nx; }
        const unsigned old = xb_add(&bar[XB_XSUB(b.x)], 1u);
        const unsigned gen = old / nloc;
        if (old + 1u == (gen + 1u) * nloc) {
            __builtin_amdgcn_fence(__ATOMIC_RELEASE, "agent");
            asm volatile("s_waitcnt vmcnt(0)" ::: "memory");
            const unsigned og = xb_add(&bar[XB_TOP], 1u);
            const unsigned tg = og / nx;
            if (og + 1u == (tg + 1u) * nx) xb_add(&bar[XB_TOPGEN], 1u);
            else XB_SPIN(xb_ld(&bar[XB_TOPGEN]) == tg, bar);
            __builtin_amdgcn_fence(__ATOMIC_ACQUIRE, "agent");
            xb_add(&bar[XB_XGEN(b.x)], 1u);
            asm volatile("s_waitcnt vmcnt(0)" ::: "memory");
        } else {
            XB_SPIN(xb_ld(&bar[XB_XGEN(b.x)]) == gen, bar);
            __builtin_amdgcn_fence(__ATOMIC_ACQUIRE, "agent");
            asm volatile("s_waitcnt vmcnt(0)" ::: "memory");
        }
    }
    __syncthreads();
}

__device__ __forceinline__ void transpose_item(const float* W, int ldw, bf16_t* WT, int ldt, int k0, int n0, int drow0, LAS float* scr, int lane) {
#pragma unroll 8
    for (int i = 0; i < 32; ++i) { const int kk = 2 * i + (lane >> 5); scr[kk * 33 + (lane & 31)] = __builtin_nontemporal_load(W + (size_t)(k0 + kk) * ldw + n0 + (lane & 31)); }
    LDS_WAIT();
    const int c = lane & 7;
#pragma unroll
    for (int j = 0; j < 4; ++j) { const int n = (lane >> 3) + 8 * j; const LAS float* s = scr + (8 * c) * 33 + n;
        u32x4 o; o.x = cvt_pk_bf16(s[0 * 33], s[1 * 33]); o.y = cvt_pk_bf16(s[2 * 33], s[3 * 33]); o.z = cvt_pk_bf16(s[4 * 33], s[5 * 33]); o.w = cvt_pk_bf16(s[6 * 33], s[7 * 33]);
        *(u32x4*)(WT + (size_t)(drow0 + n) * ldt + k0 + 8 * c) = o; }
    LDS_WAIT();
}
__device__ __forceinline__ int map_win(int n0) { return n0 < 2048 ? n0 : (n0 < 2560 ? 2048 + ((n0 - 2048) >> 7) * 256 + ((n0 - 2048) & 127) : 2048 + ((n0 - 2560) >> 7) * 256 + 128 + ((n0 - 2560) & 127)); }
__device__ __forceinline__ int map_gate(int n0) { return (n0 >> 7) * 256 + (n0 & 127); }
__device__ __forceinline__ int map_up(int n0) { return (n0 >> 7) * 256 + 128 + (n0 & 127); }

__device__ __forceinline__ void ln_row(const float* zrow, const bf16_t* zbrow, const bf16_t* yrow, float* xrow, bf16_t* brow, const f32x4 (&gv)[4], const f32x4 (&bv)[4], int lane) {
    f32x4 v[4]; float s = 0.f;
#pragma unroll
    for (int j = 0; j < 4; ++j) {
        if (zbrow) { const u32x2 zb = *(const u32x2*)(zbrow + 4 * lane + 256 * j); v[j] = (f32x4){bflo(zb.x), bfhi(zb.x), bflo(zb.y), bfhi(zb.y)}; }
        else v[j] = *(const f32x4*)(zrow + 4 * lane + 256 * j);
        if (yrow) { const u32x2 y = __builtin_nontemporal_load((const u32x2*)(yrow + 4 * lane + 256 * j)); v[j] = v[j] * ALPHA + (f32x4){bflo(y.x), bfhi(y.x), bflo(y.y), bfhi(y.y)}; }
        s += (v[j][0] + v[j][1]) + (v[j][2] + v[j][3]); }
    const float mean = wave_sum(s) * (1.f / DM); float s2 = 0.f;
#pragma unroll
    for (int j = 0; j < 4; ++j) { v[j] = v[j] - mean; s2 += (v[j][0] * v[j][0] + v[j][1] * v[j][1]) + (v[j][2] * v[j][2] + v[j][3] * v[j][3]); }
    const float rstd = 1.0f / sqrtf(wave_sum(s2) * (1.f / DM) + LN_EPS);
#pragma unroll
    for (int j = 0; j < 4; ++j) { const f32x4 y = v[j] * rstd * gv[j] + bv[j];
        if (xrow) __builtin_nontemporal_store(y, (f32x4*)(xrow + 4 * lane + 256 * j));
        if (brow) { u32x2 w; w.x = cvt_pk_bf16(y[0], y[1]); w.y = cvt_pk_bf16(y[2], y[3]); *(u32x2*)(brow + 4 * lane + 256 * j) = w; } }
}
__device__ __forceinline__ void ln_pass(const float* Z, const bf16_t* Zb, const bf16_t* Y, float* Xf, bf16_t* Xb_, const float* g, const float* b, int rows, int gw, int NGW, int lane) {
    f32x4 gv[4], bv[4];
#pragma unroll
    for (int j = 0; j < 4; ++j) { gv[j] = *(const f32x4*)(g + 4 * lane + 256 * j); bv[j] = *(const f32x4*)(b + 4 * lane + 256 * j); }
    for (int r = gw; r < rows; r += NGW) ln_row(Z ? Z + (size_t)r * DM : nullptr, Zb ? Zb + (size_t)r * DM : nullptr, Y ? Y + (size_t)r * DM : nullptr, Xf ? Xf + (size_t)r * DM : nullptr, Xb_ ? Xb_ + (size_t)r * DM : nullptr, gv, bv, lane);
}

template <bool OUT>
__device__ __forceinline__ void hgrn_unit(LAS unsigned char* lds, int unit, const bf16_t* Hb, const float* LF, float* SLOC, float* SDEC, const float* hg_g, bf16_t* Y, int tid, int wid, int lane) {
    const int b = unit >> 6, h = (unit >> 4) & 3, seg = unit & 15;
    const int d = tid & 127, tq = tid >> 7, r = lane & 15, g = lane >> 4;
    LAS unsigned char* QT = lds; LAS unsigned char* KT = lds + 8704; LAS unsigned char* KET = lds + 17408; LAS unsigned char* VT = lds + 27648;
    LAS float* DEC = (LAS float*)(lds + 37888); LAS float* TOT = (LAS float*)(lds + 38400); LAS float* OL = (LAS float*)(lds + 40448);
    LAS unsigned char* ST = lds + 57344 + wid * 4352; LAS unsigned char* PP = lds + 92160 + wid * 2560;
    f32x4 accS[8];
    float* sl = SLOC + (size_t)unit * 16384 + wid * 2048 + lane;
    if (OUT) {
#pragma unroll
        for (int di = 0; di < 8; ++di) {
#pragma unroll
            for (int i = 0; i < 4; ++i) accS[di][i] = sl[(di * 4 + i) * 64];
            u32x2 w; w.x = cvt_pk_bf16(accS[di][0], accS[di][1]); w.y = cvt_pk_bf16(accS[di][2], accS[di][3]);
            *(LAS u32x2*)(ST + r * 272 + (16 * di + 4 * g) * 2) = w; }
    } else {
#pragma unroll
        for (int di = 0; di < 8; ++di) accS[di] = (f32x4){0.f, 0.f, 0.f, 0.f};
    }
    float bsum = 0.f;
    const size_t tok0 = (size_t)b * SEQ + (size_t)seg * 512;
    for (int c = 0; c < 16; ++c) {
        const size_t t0 = tok0 + c * 32 + tq * 8;
        float lf[8]; unsigned short kk[8], vv[8], qq[8];
#pragma unroll
        for (int i = 0; i < 8; ++i) { lf[i] = LF[(t0 + i) * 512 + h * 128 + d]; kk[i] = Hb[(t0 + i) * HBW + 512 + h * 128 + d]; vv[i] = Hb[(t0 + i) * HBW + 1024 + h * 128 + d];
            if (OUT) qq[i] = Hb[(t0 + i) * HBW + h * 128 + d]; }
#pragma unroll
        for (int i = 1; i < 8; ++i) lf[i] += lf[i - 1];
        TOT[tq * 128 + d] = lf[7];
        __syncthreads();
        float off = 0.f, blast = 0.f;
#pragma unroll
        for (int j = 0; j < 4; ++j) { const float tj = TOT[j * 128 + d]; blast += tj; if (j < tq) off += tj; }
        float ke[8];
#pragma unroll
        for (int i = 0; i < 8; ++i) { const float bi = off + lf[i], kf = bf2f(kk[i]);
            ke[i] = kf * __expf(blast - bi);
            if (OUT) { const unsigned qv = cvt_pk_bf16(bf2f(qq[i]) * __expf(bi), kf * __expf(-bi));
                *(LAS unsigned short*)(QT + (8 * tq + i) * 272 + d * 2) = (unsigned short)(qv & 0xffffu);
                *(LAS unsigned short*)(KT + (8 * tq + i) * 272 + d * 2) = (unsigned short)(qv >> 16); } }
        { u32x4 w; w.x = cvt_pk_bf16(ke[0], ke[1]); w.y = cvt_pk_bf16(ke[2], ke[3]); w.z = cvt_pk_bf16(ke[4], ke[5]); w.w = cvt_pk_bf16(ke[6], ke[7]);
          *(LAS u32x4*)(KET + d * 80 + 16 * tq) = w;
          u32x4 x; x.x = (unsigned)vv[0] | ((unsigned)vv[1] << 16); x.y = (unsigned)vv[2] | ((unsigned)vv[3] << 16); x.z = (unsigned)vv[4] | ((unsigned)vv[5] << 16); x.w = (unsigned)vv[6] | ((unsigned)vv[7] << 16);
          *(LAS u32x4*)(VT + d * 80 + 16 * tq) = x; }
        if (tq == 0) { DEC[d] = __expf(blast); bsum += blast; }
        __syncthreads();
        u32x4 sgp; f32x4 g0p, g1p;
        if (OUT) { const int t_ = tid >> 4, v0_ = (tid & 15) * 8; sgp = *(const u32x4*)(Hb + (tok0 + c * 32 + t_) * HBW + 1536 + h * 128 + v0_);
            g0p = *(const f32x4*)(hg_g + h * 128 + v0_); g1p = *(const f32x4*)(hg_g + h * 128 + v0_ + 4); }
        const bf16x8 bv = *(const LAS bf16x8*)(VT + (16 * wid + r) * 80 + 16 * g);
        if (OUT) {
#pragma unroll
            for (int ti = 0; ti < 2; ++ti)
#pragma unroll
                for (int si = 0; si < 2; ++si) {
                    f32x4 sc = (f32x4){0.f, 0.f, 0.f, 0.f};
                    if (si <= ti) {
#pragma unroll
                        for (int k4 = 0; k4 < 4; ++k4) { const bf16x8 a = *(const LAS bf16x8*)(KT + (16 * si + r) * 272 + 64 * k4 + 16 * g), q = *(const LAS bf16x8*)(QT + (16 * ti + r) * 272 + 64 * k4 + 16 * g);
                            sc = __builtin_amdgcn_mfma_f32_16x16x32_bf16(a, q, sc, 0, 0, 0); }
                        if (si == ti) {
#pragma unroll
                            for (int i = 0; i < 4; ++i) if (4 * g + i > r) sc[i] = 0.f; }
                    }
                    u32x2 w; w.x = cvt_pk_bf16(sc[0], sc[1]); w.y = cvt_pk_bf16(sc[2], sc[3]);
                    *(LAS u32x2*)(PP + (16 * ti + r) * 80 + (16 * si + 4 * g) * 2) = w;
                }
            LDS_WAIT();
#pragma unroll
            for (int ti = 0; ti < 2; ++ti) {
                f32x4 o = (f32x4){0.f, 0.f, 0.f, 0.f};
                { const bf16x8 a = *(const LAS bf16x8*)(PP + (16 * ti + r) * 80 + 16 * g); o = __builtin_amdgcn_mfma_f32_16x16x32_bf16(a, bv, o, 0, 0, 0); }
#pragma unroll
                for (int k4 = 0; k4 < 4; ++k4) { const bf16x8 a = *(const LAS bf16x8*)(QT + (16 * ti + r) * 272 + 64 * k4 + 16 * g), s = *(const LAS bf16x8*)(ST + r * 272 + 64 * k4 + 16 * g);
                    o = __builtin_amdgcn_mfma_f32_16x16x32_bf16(a, s, o, 0, 0, 0); }
#pragma unroll
                for (int i = 0; i < 4; ++i) OL[(16 * ti + 4 * g + i) * 132 + 16 * wid + r] = o[i];
            }
            LDS_WAIT();
        }
#pragma unroll
        for (int di = 0; di < 8; ++di) { const f32x4 dec = *(const LAS f32x4*)(DEC + 16 * di + 4 * g); const bf16x8 a = *(const LAS bf16x8*)(KET + (16 * di + r) * 80 + 16 * g);
            accS[di] = accS[di] * dec; accS[di] = __builtin_amdgcn_mfma_f32_16x16x32_bf16(a, bv, accS[di], 0, 0, 0); }
        if (OUT) {
#pragma unroll
            for (int di = 0; di < 8; ++di) { u32x2 w; w.x = cvt_pk_bf16(accS[di][0], accS[di][1]); w.y = cvt_pk_bf16(accS[di][2], accS[di][3]);
                *(LAS u32x2*)(ST + r * 272 + (16 * di + 4 * g) * 2) = w; }
            __syncthreads();
            const int t = tid >> 4, v0 = (tid & 15) * 8; const size_t tok = tok0 + c * 32 + t;
            const f32x4 o0 = *(const LAS f32x4*)(OL + t * 132 + v0), o1 = *(const LAS f32x4*)(OL + t * 132 + v0 + 4);
            float ss = (o0[0] * o0[0] + o0[1] * o0[1]) + (o0[2] * o0[2] + o0[3] * o0[3]) + (o1[0] * o1[0] + o1[1] * o1[1]) + (o1[2] * o1[2] + o1[3] * o1[3]);
            ss += __shfl_xor(ss, 1); ss += __shfl_xor(ss, 2); ss += __shfl_xor(ss, 4); ss += __shfl_xor(ss, 8);
            const float rms = 1.0f / sqrtf(ss * (1.f / 128.f) + RMS_EPS);
            const f32x4 g0 = g0p, g1 = g1p; const u32x4 sg = sgp;
            u32x4 w;
            w.x = cvt_pk_bf16(o0[0] * rms * g0[0] * bflo(sg.x), o0[1] * rms * g0[1] * bfhi(sg.x));
            w.y = cvt_pk_bf16(o0[2] * rms * g0[2] * bflo(sg.y), o0[3] * rms * g0[3] * bfhi(sg.y));
            w.z = cvt_pk_bf16(o1[0] * rms * g1[0] * bflo(sg.z), o1[1] * rms * g1[1] * bfhi(sg.z));
            w.w = cvt_pk_bf16(o1[2] * rms * g1[2] * bflo(sg.w), o1[3] * rms * g1[3] * bfhi(sg.w));
            *(u32x4*)(Y + tok * DM + h * 128 + v0) = w;
        }
    }
    if (!OUT) {
#pragma unroll
        for (int di = 0; di < 8; ++di)
#pragma unroll
            for (int i = 0; i < 4; ++i) sl[(di * 4 + i) * 64] = accS[di][i];
        if (tq == 0) SDEC[unit * 128 + d] = __expf(bsum);
    }
    __syncthreads();
}

__device__ __forceinline__ void conv_tile(LAS unsigned char* lds, int tile, const bf16_t* Hb, const float (&w)[31], float cb, const float* lng, const float* lnb, bf16_t* Y, int tid, int wid, int lane) {
    const int t0 = tile * 16, pos0 = t0 & (SEQ - 1), c = tid;
    float acc[16];
#pragma unroll
    for (int o = 0; o < 16; ++o) acc[o] = cb;
#pragma unroll
    for (int jj = 0; jj < 46; ++jj) {
        const int tt = pos0 - 30 + jj;
        const float val = bf2f(Hb[(size_t)(t0 - 30 + jj + (tt >= 0 ? 0 : -tt)) * HBW + 2048 + c]) * (tt >= 0 ? 1.f : 0.f);
#pragma unroll
        for (int o = 0; o < 16; ++o) { const int j = jj - o; if (j >= 0 && j <= 30) acc[o] += w[j] * val; }
    }
    LAS float* CL = (LAS float*)lds;
#pragma unroll
    for (int o = 0; o < 16; ++o) CL[o * 512 + c] = acc[o];
    __syncthreads();
#pragma unroll
    for (int oo = 0; oo < 2; ++oo) { const int o = 2 * wid + oo;
        f32x4 v[2]; float s = 0.f;
#pragma unroll
        for (int j = 0; j < 2; ++j) { v[j] = *(const LAS f32x4*)(CL + o * 512 + 4 * lane + 256 * j); s += (v[j][0] + v[j][1]) + (v[j][2] + v[j][3]); }
        const float mean = wave_sum(s) * (1.f / 512.f); float s2 = 0.f;
#pragma unroll
        for (int j = 0; j < 2; ++j) { v[j] = v[j] - mean; s2 += (v[j][0] * v[j][0] + v[j][1] * v[j][1]) + (v[j][2] * v[j][2] + v[j][3] * v[j][3]); }
        const float rstd = 1.0f / sqrtf(wave_sum(s2) * (1.f / 512.f) + LN_EPS);
#pragma unroll
        for (int j = 0; j < 2; ++j) { const f32x4 gg = *(const f32x4*)(lng + 4 * lane + 256 * j), bb = *(const f32x4*)(lnb + 4 * lane + 256 * j); f32x4 y = v[j] * rstd * gg + bb;
#pragma unroll
            for (int e = 0; e < 4; ++e) y[e] = siluf_(y[e]);
            u32x2 wv; wv.x = cvt_pk_bf16(y[0], y[1]); wv.y = cvt_pk_bf16(y[2], y[3]);
            *(u32x2*)(Y + (size_t)(t0 + o) * DM + 512 + 4 * lane + 256 * j) = wv; }
    }
    __syncthreads();
}

template <int W>
__device__ __forceinline__ void pool_tile(int tile, const bf16_t* Xr, bf16_t* Pp, int tid) {
    const int t0 = tile * 16, pos0 = t0 & (SEQ - 1), c = 2 * tid;
    f32x2 xs[15 + W];
#pragma unroll
    for (int k = 0; k < 15 + W; ++k) { const int tt = pos0 - (W - 1) + k;
        const unsigned v = *(const unsigned*)(Xr + (size_t)(t0 - (W - 1) + k + (tt >= 0 ? 0 : -tt)) * DM + c); const float msk = tt >= 0 ? 1.f : 0.f; xs[k] = (f32x2){bflo(v) * msk, bfhi(v) * msk}; }
#pragma unroll
    for (int o = 0; o < 16; ++o) {
        f32x2 s = xs[o + W - 1];
#pragma unroll
        for (int i = 1; i < W; ++i) s += xs[o + W - 1 - i];
        const int pos = pos0 + o; const float inv = 1.0f / (float)(pos + 1 < W ? pos + 1 : W);
        const f32x2 p = s * inv - xs[o + W - 1];
        *(unsigned*)(Pp + (size_t)(t0 + o) * DM + c) = cvt_pk_bf16(p[0], p[1]);
    }
}

#define x_in AIN(0)
#define Win_t ((bf16_t*)WSP(WS_WIN))
#define Wout_t ((bf16_t*)WSP(WS_WOUT))
#define Wk_t ((bf16_t*)WSP(WS_WK))
#define Wv_t ((bf16_t*)WSP(WS_WV))
#define Wo_t ((bf16_t*)WSP(WS_WO))
#define Wgu_t ((bf16_t*)WSP(WS_WGU))
#define Wd_t ((bf16_t*)WSP(WS_WD))
#define Wpool_t ((bf16_t*)WSP(WS_WPOOL))
#define Memn ((bf16_t*)WSP(WS_MEMN))
#define Kmat ((bf16_t*)WSP(WS_KMAT))
#define Vmat ((bf16_t*)WSP(WS_VT))
#define Abt ((bf16_t*)WSP(WS_ABT))
#define Cbt ((bf16_t*)WSP(WS_CBT))
#define Wq_n ((bf16_t*)WSP(WS_WQ))
#define lbv ((float*)WSP(WS_LBV))
#define SDEC ((float*)WSP(WS_SDEC))
#define SLOC ((float*)WSP(WS_SLOC))
#define SST ((float*)WSP(WS_SST))
#define Xb ((bf16_t*)WSP(WS_XB))
#define LF ((float*)WSP(WS_LF))
#define Ybuf ((bf16_t*)WSP(WS_LF))
#define Hb ((bf16_t*)WSP(WS_R1))
#define Hff ((bf16_t*)WSP(WS_R1))
#define Pb ((bf16_t*)WSP(WS_R1) + (size_t)MROWS * DM)
#define Yb ((bf16_t*)WSP(WS_R3))
#define Pp ((bf16_t*)WSP(WS_R3))
#define out ((float*)get_args()->out)

#define lane lane_id_v()
#define tid (wid * 64 + lane_id_v())

#define GSYNC() xcd_barrier(xbar)
template <int l>
__device__ __forceinline__ void layer_body(LAS unsigned char* lds, const XcdBarrier& xbar, int wid, int G, int bid, int gw, int NGW) {
        if (l == 1) {
            for (int t = bid; t < MROWS / 16; t += G) {
                if (wid < 2) pool_tile<2>(t, Xb, Pp, tid); else if (wid < 4) pool_tile<4>(t, Xb, Pp, tid); else if (wid < 6) pool_tile<8>(t, Xb, Pp, tid); else pool_tile<16>(t, Xb, Pp, tid);
            }
            GSYNC();
            { pg8::Gemm g = pg8::mk_gemm(Pp, Wpool_t, DM, 256, 256); g.a_pn_off = 256; pg8::Order S; S.init(MROWS / 256, 4, G, bid);
              pg8::EpiStoreBf16 E{Ybuf, DM, 1.0f, AIN(13)}; pg8::gemm_phase(lds, g, S, E, wid); }
            GSYNC();
            ln_pass(nullptr, Xb, Ybuf, nullptr, Xb, AIN(14) + DM, AIN(15) + DM, MROWS, gw, NGW, lane);
            GSYNC();
        }
        { pg8::Gemm g = pg8::mk_gemm(Xb, Abt + (size_t)l * 4096 * DM, DM, DM, DM); g.b_sh = 5; g.b_hi = (long)DM * DM;
          pg8::Order S; S.init(MROWS / 256, 4, G, bid);
          pg8::EpiSoftmax E{(LAS float*)(lds + XCH_OFF)}; pg8::gemm_phase(lds, g, S, E, wid); }
        GSYNC();
        { pg8::Gemm g = pg8::mk_gemm(Pb, Cbt + (size_t)l * 4096 * DM, DM, DM, DM); g.b_sh = 5; g.b_hi = (long)DM * DM;
          pg8::Order S; S.init(MROWS / 256, 4, G, bid);
          pg8::EpiStoreBf16 E{Ybuf, DM, 1.0f, nullptr}; pg8::gemm_phase(lds, g, S, E, wid); }
        GSYNC();
        ln_pass(nullptr, Xb, Ybuf, nullptr, Xb, AIN(20) + l * DM, AIN(21) + l * DM, MROWS, gw, NGW, lane);
        GSYNC();
        { pg8::Gemm g = pg8::mk_gemm(Xb, Wgu_t + (size_t)l * 2 * FF * DM, DM, DM, DM); pg8::Order S; S.init(MROWS / 256, 2 * FF / 256, G, bid);
          pg8::EpiSwiGLU E{Hff, FF}; pg8::gemm_phase(lds, g, S, E, wid); }
        GSYNC();
        { pg8::Gemm g = pg8::mk_gemm(Hff, Wd_t + (size_t)l * DM * FF, FF, FF, FF); pg8::Order S; S.init(MROWS / 256, 4, G, bid);
          pg8::EpiStoreBf16 E{Ybuf, DM, 1.0f, nullptr}; pg8::gemm_phase(lds, g, S, E, wid); }
        GSYNC();
        ln_pass(nullptr, Xb, Ybuf, l == 1 ? out : nullptr, l == 1 ? nullptr : Xb, AIN(25) + l * DM, AIN(26) + l * DM, MROWS, gw, NGW, lane);
        if (l == 0) GSYNC();
    }

__global__ void __launch_bounds__(512, 2) fwd_megakernel(Args a_unused) {
    extern __shared__ __attribute__((aligned(16))) unsigned char lds_raw[];
    LAS unsigned char* lds = (LAS unsigned char*)lds_raw;
    cg::grid_group grid = cg::this_grid();
    const int wid = __builtin_amdgcn_readfirstlane((int)threadIdx.x >> 6);
#define lane lane_id_v()
#define tid (wid * 64 + lane_id_v())
    const int G = gridDim.x, bid = blockIdx.x, gw = bid * 8 + wid, NGW = G * 8;

    volatile LAS unsigned* xst = (volatile LAS unsigned*)(lds + XCH_OFF + 8192);
    if (tid < 2) xst[tid] = 0u;
    __syncthreads();
    const XcdBarrier xbar = xcd_barrier_post((unsigned*)WSP(WS_BAR), xst);
    if (G == 0x7fffffff) grid.sync();
    {
        LAS float* scr = (LAS float*)(lds + wid * 16384);
        const float* w_in = AIN(5); const float* w_out = AIN(11); const float* pool_w = AIN(12);
        constexpr int C_WIN = 16 * 96, C_SQ = 16 * 32, C_GU = 16 * 88, C_WD = 44 * 32, C_POOL = 4 * 8;
        constexpr int C_LAYER = 4 * C_SQ + 2 * C_GU + C_WD;
        constexpr int NITEMS = C_WIN + C_SQ + 2 * C_LAYER + 4 * C_POOL;
        for (int it = gw; it < NITEMS; it += NGW) {
            int r = it;
            if (r < C_WIN) { const int kb = r / 96, n0 = (r % 96) * 32; transpose_item(w_in, INCOLS, Win_t, DM, kb * 64, n0, map_win(n0), scr, lane); continue; }
            r -= C_WIN;
            if (r < C_SQ) { const int kb = r / 32, n0 = (r % 32) * 32; transpose_item(w_out, DM, Wout_t, DM, kb * 64, n0, n0, scr, lane); continue; }
            r -= C_SQ;
            if (r < 2 * C_LAYER) {
                const int l = r / C_LAYER; r -= l * C_LAYER;
                if (r < 4 * C_SQ) { const int q = r / C_SQ; r -= q * C_SQ; const int kb = r / 32, n0 = (r % 32) * 32; if (q == 0) continue;
                    const float* src = AIN(16 + q) + (size_t)l * DM * DM; bf16_t* dst = (q == 1 ? Wk_t : q == 2 ? Wv_t : Wo_t) + (size_t)l * DM * DM;
                    transpose_item(src, DM, dst, DM, kb * 64, n0, n0, scr, lane); continue; }
                r -= 4 * C_SQ;
                if (r < 2 * C_GU) { const int q = r / C_GU; r -= q * C_GU; const int kb = r / 88, n0 = (r % 88) * 32;
                    transpose_item(AIN(22 + q) + (size_t)l * DM * FF, FF, Wgu_t + (size_t)l * 2 * FF * DM, DM, kb * 64, n0, q == 0 ? map_gate(n0) : map_up(n0), scr, lane); continue; }
                r -= 2 * C_GU;
                { const int kb = r / 32, n0 = (r % 32) * 32; transpose_item(AIN(24) + (size_t)l * FF * DM, DM, Wd_t + (size_t)l * DM * FF, FF, kb * 64, n0, n0, scr, lane); continue; }
            }
            r -= 2 * C_LAYER;
            { const int gi = r / C_POOL, rr = r % C_POOL, kb = rr / 8, n0 = (rr % 8) * 32; transpose_item(pool_w + (size_t)gi * 65536, 256, Wpool_t, 256, kb * 64, n0, gi * 256 + n0, scr, lane); }
        }
        { const size_t n8 = (size_t)MROWS * DM / 8;
          for (size_t i = (size_t)bid * 512 + tid; i < n8; i += (size_t)G * 512) { const f32x4 v0 = __builtin_nontemporal_load((const f32x4*)(x_in + i * 8)), v1 = __builtin_nontemporal_load((const f32x4*)(x_in + i * 8 + 4));
              u32x4 w; w.x = cvt_pk_bf16(v0[0], v0[1]); w.y = cvt_pk_bf16(v0[2], v0[3]); w.z = cvt_pk_bf16(v1[0], v1[1]); w.w = cvt_pk_bf16(v1[2], v1[3]);
              *(u32x4*)(Xb + i * 8) = w; } }
        { const float* wq = AIN(16); const size_t n8 = (size_t)2 * DM * DM / 8;
          for (size_t i = (size_t)bid * 512 + tid; i < n8; i += (size_t)G * 512) { const f32x4 v0 = __builtin_nontemporal_load((const f32x4*)(wq + i * 8)), v1 = __builtin_nontemporal_load((const f32x4*)(wq + i * 8 + 4));
              u32x4 w; w.x = cvt_pk_bf16(v0[0], v0[1]); w.y = cvt_pk_bf16(v0[2], v0[3]); w.z = cvt_pk_bf16(v1[0], v1[1]); w.w = cvt_pk_bf16(v1[2], v1[3]);
              *(u32x4*)(Wq_n + i * 8) = w; } }
        ln_pass(AIN(1), nullptr, nullptr, nullptr, Memn, AIN(3), AIN(4), MEMROWS, gw, NGW, lane);
        if (bid == 0) { const float* lp = AIN(2); const float p0 = lp[tid], p1 = lp[512 + tid], p2 = lp[1024 + tid]; const float mx = fmaxf(p0, fmaxf(p1, p2));
            const float e0 = __expf(p0 - mx), e1 = __expf(p1 - mx), e2 = __expf(p2 - mx); lbv[tid] = e0 / (e0 + e1 + e2); }
    }
    GSYNC();

    {
        pg8::Gemm g = pg8::mk_gemm(Xb, Win_t, DM, DM, DM); pg8::Order S; S.init(MROWS / 256, INCOLS / 256, G, bid);
        pg8::EpiWin E{Hb, LF, lbv};
        pg8::gemm_phase(lds, g, S, E, wid);
    }
    GSYNC();

    {
        for (int u = bid; u < 256; u += G) hgrn_unit<false>(lds, u, Hb, LF, SLOC, SDEC, AIN(6), Yb, tid, wid, lane);
        float w[31];
#pragma unroll
        for (int j = 0; j < 31; ++j) w[j] = AIN(7)[j * 512 + tid];
        const float cb = AIN(8)[tid];
        for (int t = bid; t < MROWS / 16; t += G) conv_tile(lds, t, Hb, w, cb, AIN(9), AIN(10), Yb, tid, wid, lane);
    }
    GSYNC();
    {
        for (int l = 0; l < 2; ++l) {
            { pg8::Gemm gk = pg8::mk_gemm(Memn, Wk_t + (size_t)l * DM * DM, DM, DM, DM); pg8::Order Sk; Sk.init(4, 4, G, (bid + G - (32 * l) % G) % G);
              pg8::EpiStoreBf16 Ek{Kmat + (size_t)l * MEMROWS * DM, DM, 1.0f, nullptr}; pg8::gemm_phase(lds, gk, Sk, Ek, wid); }
            { pg8::Gemm gv = pg8::mk_gemm(Memn, Wv_t + (size_t)l * DM * DM, DM, DM, DM); pg8::Order Sv; Sv.init(4, 4, G, (bid + G - (32 * l + 16) % G) % G);
              pg8::EpiStoreBf16 Ev{Vmat + (size_t)l * MEMROWS * DM, DM, 1.0f, nullptr}; pg8::gemm_phase(lds, gv, Sv, Ev, wid); }
        }
    }
    {
        const int e = bid * 512 + tid;
        for (int idx = e; idx < 16 * 16384; idx += G * 512) {
            const int bh = idx >> 14, rem = idx & 16383, reg = (rem >> 6) & 31, ln = rem & 63, dd = 16 * (reg >> 2) + 4 * (ln >> 4) + (reg & 3);
            float cur = 0.f;
            for (int sgi = 0; sgi < 16; ++sgi) { const int unit = bh * 16 + sgi; const float tmp = SLOC[(size_t)unit * 16384 + rem]; SST[(size_t)unit * 16384 + rem] = cur; cur = SDEC[unit * 128 + dd] * cur + tmp; }
        }
    }
    GSYNC();
    for (int l2 = 0; l2 < 2; ++l2) {
        { pg8::Gemm ga = pg8::mk_gemm(Kmat + (size_t)l2 * MEMROWS * DM, Wq_n + (size_t)l2 * DM * DM, DM, DM, 256);
          ga.a_sh = 2; ga.a_hi = (long)256 * DM; ga.a_mask = 3; ga.a_lo = 256; ga.b_mask = 3; ga.b_lo = 256;
          pg8::Order Sa; Sa.init(16, 4, G, (bid + G - (128 * l2) % G) % G);
          pg8::EpiStoreBf16 Ea{Abt + (size_t)l2 * 4096 * DM, DM, 0.0625f, nullptr}; pg8::gemm_phase(lds, ga, Sa, Ea, wid); }
        { pg8::Gemm gc = pg8::mk_gemm(Wo_t + (size_t)l2 * DM * DM, Vmat + (size_t)l2 * MEMROWS * DM, DM, DM, 256);
          gc.a_sh = 0; gc.a_hi = 0; gc.a_mask = 3; gc.a_lo = (long)256 * DM; gc.a_pn_off = 256; gc.b_pn_off = 256; gc.b_sh = 2; gc.b_hi = (long)256 * DM;
          pg8::Order Sc; Sc.init(16, 4, G, (bid + G - (128 * l2 + 64) % G) % G);
          pg8::EpiStoreBf16 Ec{Cbt + (size_t)l2 * 4096 * DM, DM, 1.0f, nullptr}; pg8::gemm_phase(lds, gc, Sc, Ec, wid); }
    }
    for (int u = bid; u < 256; u += G) hgrn_unit<true>(lds, u, Hb, LF, SST, SDEC, AIN(6), Yb, tid, wid, lane);
    GSYNC();
    {
        pg8::Gemm g = pg8::mk_gemm(Yb, Wout_t, DM, DM, DM); pg8::Order S; S.init(MROWS / 256, 4, G, bid);
        pg8::EpiStoreBf16 E{Ybuf, DM, 1.0f, nullptr}; pg8::gemm_phase(lds, g, S, E, wid);
    }
    GSYNC();
    ln_pass(x_in, nullptr, Ybuf, nullptr, Xb, AIN(14), AIN(15), MROWS, gw, NGW, lane);
    GSYNC();

    layer_body<0>(lds, xbar, wid, G, bid, gw, NGW);
    layer_body<1>(lds, xbar, wid, G, bid, gw, NGW);
}

#undef lane
#undef tid
#undef out
#undef x_in
extern "C" void kernel_launch(void* const* d_in, const int* in_sizes, int n_in, void* d_out, int out_size, void* d_ws, size_t ws_size, hipStream_t stream) {
    static int grid = 0;
    if (grid == 0) {
        if (n_in != 27 || out_size != MROWS * DM || ws_size < WS_END) { fprintf(stderr, "kernel_launch: unexpected problem (n_in %d, out %d, ws %zu)\n", n_in, out_size, ws_size); grid = -1; return; }
        int dev = 0, cus = 0, per_cu = 0;
        (void)hipGetDevice(&dev);
        (void)hipDeviceGetAttribute(&cus, hipDeviceAttributeMultiprocessorCount, dev);
        (void)hipFuncSetAttribute((const void*)fwd_megakernel, hipFuncAttributeMaxDynamicSharedMemorySize, LDS_BYTES);
        (void)hipOccupancyMaxActiveBlocksPerMultiprocessor(&per_cu, (const void*)fwd_megakernel, 512, LDS_BYTES);
        if (per_cu < 1) { fprintf(stderr, "kernel_launch: occupancy query reports %d blocks per CU\n", per_cu); }
        grid = cus;
    }
    if (grid < 0) return;
    if (hipMemsetAsync((char*)d_ws + WS_BAR, 0, XCD_BAR_WORDS * sizeof(unsigned), stream) != hipSuccess) { fprintf(stderr, "kernel_launch: hipMemsetAsync failed\n"); return; }
    Args a{};
    for (int i = 0; i < 27; ++i) a.in[i] = (const float*)d_in[i];
    a.out = (float*)d_out; a.ws = (unsigned char*)d_ws;
    void* args[] = {&a};
    hipError_t e = hipLaunchCooperativeKernel((const void*)fwd_megakernel, dim3(grid), dim3(512), args, LDS_BYTES, stream);
    if (e != hipSuccess) fprintf(stderr, "cooperative launch failed: %s (grid %d)\n", hipGetErrorString(e), grid);
}
```

```cpp
#include <hip/hip_runtime.h>
#include <hip/hip_cooperative_groups.h>
#include <cstdio>
#include <cstdint>
namespace cg = cooperative_groups;

#define LAS __attribute__((address_space(3)))
typedef unsigned short bf16_t;
typedef short bf16x8 __attribute__((ext_vector_type(8)));
typedef float f32x4 __attribute__((ext_vector_type(4)));
typedef float f32x2 __attribute__((ext_vector_type(2)));
typedef unsigned u32x4 __attribute__((ext_vector_type(4)));
typedef unsigned u32x2 __attribute__((ext_vector_type(2)));

#define LDS_WAIT() asm volatile("s_waitcnt lgkmcnt(0)" ::: "memory")
#define VM_WAIT() asm volatile("s_waitcnt vmcnt(0)" ::: "memory")

constexpr int DM = 1024, NBATCH = 4, SEQ = 8192, MROWS = NBATCH * SEQ, MEMLEN = 256, MEMROWS = NBATCH * MEMLEN, FF = 2816, INCOLS = 3072;
constexpr int HBW = 2560;
constexpr float ALPHA = 1.4142135623730951f;
constexpr float LN_EPS = 1e-5f, RMS_EPS = 1e-6f;

constexpr size_t MiB = (size_t)1 << 20;
constexpr size_t WS_WIN = 0 * MiB, WS_WOUT = 6 * MiB, WS_WQ = 8 * MiB, WS_WK = 12 * MiB, WS_WV = 16 * MiB, WS_WO = 20 * MiB, WS_WGU = 24 * MiB, WS_WD = 46 * MiB,
                 WS_WPOOL = 57 * MiB, WS_MEMN = 58 * MiB, WS_KMAT = 60 * MiB, WS_VT = 64 * MiB, WS_LBV = 68 * MiB, WS_BAR = 68 * MiB + 65536, WS_SDEC = 69 * MiB, WS_SLOC = 70 * MiB,
                 WS_XB = 88 * MiB, WS_R3 = 152 * MiB, WS_LF = 216 * MiB, WS_R1 = 280 * MiB, WS_SST = 456 * MiB, WS_ABT = 472 * MiB, WS_CBT = 488 * MiB, WS_END = 504 * MiB;
constexpr int RING_BYTES = 131072, XCH_OFF = RING_BYTES, LDS_BYTES = RING_BYTES + 8192 + 1024;

struct Args { const float* in[27]; float* out; unsigned char* ws; };

typedef const __attribute__((address_space(4))) Args* CArgs;
__device__ __forceinline__ CArgs get_args() { CArgs p = (CArgs)__builtin_amdgcn_kernarg_segment_ptr(); asm volatile("" : "+s"(p)); return p; }
#define AIN(i) ((const float*)get_args()->in[i])
#define WSP(off) ((unsigned char*)get_args()->ws + (off))


__device__ __forceinline__ int lane_id_v() { int l; asm volatile("v_mbcnt_lo_u32_b32 %0, -1, 0\n\tv_mbcnt_hi_u32_b32 %0, -1, %0" : "=v"(l)); return l; }
typedef __bf16 bf16x2_t __attribute__((ext_vector_type(2)));
__device__ __forceinline__ unsigned cvt_pk_bf16(float lo, float hi) { f32x2 f = {lo, hi}; bf16x2_t v = __builtin_convertvector(f, bf16x2_t); return __builtin_bit_cast(unsigned, v); }
__device__ __forceinline__ float bf2f(unsigned short v) { return __uint_as_float(((unsigned)v) << 16); }
__device__ __forceinline__ float bflo(unsigned v) { return __uint_as_float(v << 16); }
__device__ __forceinline__ float bfhi(unsigned v) { return __uint_as_float(v & 0xffff0000u); }
__device__ __forceinline__ float sigmoidf_(float x) { return __builtin_amdgcn_rcpf(1.0f + __expf(-x)); }
__device__ __forceinline__ float siluf_(float x) { return x * sigmoidf_(x); }
__device__ __forceinline__ float wave_sum(float v) {
#pragma unroll
    for (int o = 1; o < 64; o <<= 1) v += __shfl_xor(v, o);
    return v;
}

namespace pg8 {
constexpr int BM = 256, BK = 64, HALF = 128, HTB = HALF * BK * 2, NXCD = 8, WGM = 8;
__device__ __forceinline__ int lds_byte(int r, int c) { const int st = (r >> 4) * 2 + (c >> 5), rr = r & 15, cc = c & 31, ob = rr * 64 + cc * 2; return st * 1024 + (ob ^ (((ob >> 9) & 1) << 5)); }
__device__ __forceinline__ void stage_rc(int b, int& R, int& C) { const int st = b / 1024, sb = b % 1024, swz = sb ^ (((sb >> 9) & 1) << 5); R = (st >> 1) * 16 + swz / 64; C = (st & 1) * 32 + (swz % 64) / 2; }
__device__ __forceinline__ int perm32(int rho) { const int n = rho >> 4, i = rho & 15; return 8 * (i >> 2) + 4 * n + (i & 3); }

struct Unit { int pm, pn; };
struct Gemm { const bf16_t* A; const bf16_t* Bt; int lda, ldb, K; long a_pn_off; int a_sh, a_mask; long a_hi, a_lo; long b_pn_off; int b_sh, b_mask; long b_hi, b_lo; };
__device__ __forceinline__ Gemm mk_gemm(const bf16_t* A, const bf16_t* Bt, int lda, int ldb, int K) { Gemm g; g.A = A; g.Bt = Bt; g.lda = lda; g.ldb = ldb; g.K = K;
    g.a_pn_off = 0; g.a_sh = 0; g.a_mask = 0; g.a_hi = (long)BM * lda; g.a_lo = 0; g.b_pn_off = (long)BM * ldb; g.b_sh = 0; g.b_mask = 0; g.b_hi = 0; g.b_lo = 0; return g; }
__device__ __forceinline__ const char* unitA(const Gemm& g, const Unit& u) { return (const char*)(g.A + (size_t)(u.pm >> g.a_sh) * g.a_hi + (size_t)(u.pm & g.a_mask) * g.a_lo + (size_t)u.pn * g.a_pn_off); }
__device__ __forceinline__ const char* unitB(const Gemm& g, const Unit& u) { return (const char*)(g.Bt + (size_t)u.pn * g.b_pn_off + (size_t)(u.pm >> g.b_sh) * g.b_hi + (size_t)(u.pm & g.b_mask) * g.b_lo); }

struct Order {
    int nM, nN, nwg, G, c;
    __device__ void init(int nM_, int nN_, int G_, int c_) { nM = nM_; nN = nN_; nwg = nM * nN; G = G_; c = c_; }
    __device__ bool next(int i, Unit& u) const {
        const long L = (long)i * G + c; if (L >= nwg) return false;
        int wgid = (int)L; { const int q = nwg / NXCD, r = nwg % NXCD, xcd = wgid % NXCD, off = wgid / NXCD; wgid = (xcd < r ? xcd * (q + 1) : r * (q + 1) + (xcd - r) * q) + off; }
        const int nig = WGM * nN, gid = wgid / nig, fm = gid * WGM, gsz = (nM - fm) < WGM ? (nM - fm) : WGM;
        u.pm = fm + ((wgid % nig) % gsz); u.pn = (wgid % nig) / gsz; return true;
    }
};

template <class Epi>
__device__ __forceinline__ void gemm_phase(LAS unsigned char* lds, const Gemm g, const Order& S, const Epi& E, const int wid) {
    const int lane = lane_id_v(), tid = wid * 64 + lane;
    const int wr = wid >> 2, wc = wid & 3, fr = lane & 15, fq = lane >> 4;
    const int nt = g.K / BK;
    unsigned voffA[2], voffB[2];
#pragma unroll
    for (int i = 0; i < 2; ++i) { int R, C; stage_rc(tid * 16 + i * 8192, R, C); const int Rb = Epi::PERM ? ((R & ~31) + perm32(R & 31)) : R;
        voffA[i] = (unsigned)(R * g.lda + C) * 2u; voffB[i] = (unsigned)(Rb * g.ldb + C) * 2u; }
    const size_t kstep = (size_t)(BK * 2);
    const size_t hstepA = (size_t)HALF * g.lda * 2, hstepB = (size_t)HALF * g.ldb * 2;
    const unsigned ldsw = (unsigned)wid * 1024u;
    const int aoff = lds_byte(wr * 64 + fr, fq * 8), boff = lds_byte(wc * 32 + fr, fq * 8);
#define PG8_SA(b, h) (((b) * 2 + (h)) * HTB)
#define PG8_SB(b, h) ((4 + (b) * 2 + (h)) * HTB)
#define PG8_STAGE(bufoff, gbase, voff) do { _Pragma("unroll") for (int _i = 0; _i < 2; ++_i) \
        __builtin_amdgcn_global_load_lds((const unsigned*)((const char*)(gbase) + (voff)[_i]), (LAS unsigned*)(lds + (bufoff) + ldsw + _i * 8192), 16, 0, 0); } while (0)
#define PG8_LDA(dst, b, h) do { _Pragma("unroll") for (int m = 0; m < 4; ++m) _Pragma("unroll") for (int k = 0; k < 2; ++k) dst[m][k] = *(const LAS bf16x8*)(lds + PG8_SA(b, h) + aoff + m * 2048 + k * 1024); } while (0)
#define PG8_LDB(dst, b, h) do { _Pragma("unroll") for (int n = 0; n < 2; ++n) _Pragma("unroll") for (int k = 0; k < 2; ++k) dst[n][k] = *(const LAS bf16x8*)(lds + PG8_SB(b, h) + boff + n * 2048 + k * 1024); } while (0)
#define PG8_MMA(ai, bj, At, Bt) do { __builtin_amdgcn_s_setprio(1); _Pragma("unroll") for (int m = 0; m < 4; ++m) _Pragma("unroll") for (int n = 0; n < 2; ++n) _Pragma("unroll") for (int k = 0; k < 2; ++k) \
        acc[ai][bj][m][n] = __builtin_amdgcn_mfma_f32_16x16x32_bf16(Bt[n][k], At[m][k], acc[ai][bj][m][n], 0, 0, 0); __builtin_amdgcn_s_setprio(0); } while (0)
#define PG8_WAIT_V(n) asm volatile("s_waitcnt vmcnt(" #n ")" ::: "memory")
#define PG8_WAIT_L(n) asm volatile("s_waitcnt lgkmcnt(" #n ")" ::: "memory")
#define PG8_BAR __builtin_amdgcn_s_barrier()
#define PG8_SCHED __builtin_amdgcn_sched_barrier(0)
    Unit cur, nxt; int ui = 0;
    if (!S.next(0, cur)) return;
    f32x4 acc[2][2][4][2];
#pragma unroll
    for (int a = 0; a < 2; ++a)
#pragma unroll
        for (int b = 0; b < 2; ++b)
#pragma unroll
            for (int m = 0; m < 4; ++m)
#pragma unroll
                for (int n = 0; n < 2; ++n) acc[a][b][m][n] = (f32x4){0.f, 0.f, 0.f, 0.f};
    bf16x8 At[4][2], B0[2][2], B1[2][2];
    const char* cA = unitA(g, cur); const char* cB = unitB(g, cur);
    PG8_STAGE(PG8_SB(0, 0), cB, voffB); PG8_STAGE(PG8_SB(0, 1), cB + hstepB, voffB); PG8_STAGE(PG8_SA(0, 0), cA, voffA); PG8_STAGE(PG8_SA(0, 1), cA + hstepA, voffA);
    if (wr == 1) PG8_BAR;
    PG8_WAIT_V(2); PG8_BAR;
    PG8_STAGE(PG8_SB(1, 0), cB + kstep, voffB); PG8_STAGE(PG8_SA(1, 0), cA + kstep, voffA); PG8_STAGE(PG8_SB(1, 1), cB + hstepB + kstep, voffB);
    PG8_WAIT_V(6); PG8_BAR;
    for (;;) {
        const bool has_next = S.next(ui + 1, nxt);
        const char* nA = has_next ? unitA(g, nxt) : cA; const char* nB = has_next ? unitB(g, nxt) : cB;
        for (int t = 0; t < nt; t += 2) {
            const bool last = (t == nt - 2);
            const char* a1 = cA + (size_t)(t + 1) * kstep;
            const char* a2 = last ? nA : cA + (size_t)(t + 2) * kstep; const char* b2 = last ? nB : cB + (size_t)(t + 2) * kstep;
            const char* a3 = a2 + kstep; const char* b3 = b2 + kstep;
            PG8_LDB(B0, 0, 0); PG8_LDB(B1, 0, 1); PG8_SCHED; PG8_LDA(At, 0, 0); PG8_STAGE(PG8_SA(1, 1), a1 + hstepA, voffA);
            PG8_WAIT_V(8); PG8_WAIT_L(0); PG8_BAR; PG8_MMA(0, 0, At, B0); PG8_MMA(0, 1, At, B1); PG8_BAR; PG8_SCHED;
            PG8_LDA(At, 0, 1); PG8_STAGE(PG8_SB(0, 0), b2, voffB); PG8_STAGE(PG8_SB(0, 1), b2 + hstepB, voffB); PG8_STAGE(PG8_SA(0, 0), a2, voffA);
            PG8_WAIT_V(8); PG8_WAIT_L(0); PG8_BAR; PG8_MMA(1, 0, At, B0); PG8_MMA(1, 1, At, B1); PG8_BAR; PG8_SCHED;
            PG8_LDB(B0, 1, 0); PG8_LDB(B1, 1, 1); PG8_SCHED; PG8_LDA(At, 1, 0); PG8_STAGE(PG8_SA(0, 1), a2 + hstepA, voffA);
            PG8_WAIT_V(8); PG8_WAIT_L(0); PG8_BAR; PG8_MMA(0, 0, At, B0); PG8_MMA(0, 1, At, B1); PG8_BAR; PG8_SCHED;
            PG8_LDA(At, 1, 1); PG8_STAGE(PG8_SB(1, 0), b3, voffB); PG8_STAGE(PG8_SB(1, 1), b3 + hstepB, voffB); PG8_STAGE(PG8_SA(1, 0), a3, voffA);
            PG8_WAIT_V(8); PG8_WAIT_L(0); PG8_BAR; PG8_MMA(1, 0, At, B0); PG8_MMA(1, 1, At, B1); PG8_BAR; PG8_SCHED;
        }
        if (wr == 0) PG8_BAR;
        { int fr_ = fr, fq_ = fq; asm volatile("" : "+v"(fr_), "+v"(fq_));
          E(acc, cur, wr, wc, fr_, fq_); }
        if (!has_next) break;
#pragma unroll
        for (int a = 0; a < 2; ++a)
#pragma unroll
            for (int b = 0; b < 2; ++b)
#pragma unroll
                for (int m = 0; m < 4; ++m)
#pragma unroll
                    for (int n = 0; n < 2; ++n) acc[a][b][m][n] = (f32x4){0.f, 0.f, 0.f, 0.f};
        cur = nxt; cA = nA; cB = nB; ++ui;
        if (wr == 1) PG8_BAR;
    }
    PG8_WAIT_V(0);
    PG8_BAR;
#undef PG8_SA
#undef PG8_SB
#undef PG8_STAGE
#undef PG8_LDA
#undef PG8_LDB
#undef PG8_MMA
#undef PG8_WAIT_V
#undef PG8_WAIT_L
#undef PG8_BAR
#undef PG8_SCHED
}

typedef const f32x4 (&AccRef)[2][2][4][2];

struct EpiStoreBf16 {
    static constexpr bool PERM = true;
    bf16_t* O; int ldc; float scale; const float* colscale;
    __device__ __forceinline__ void operator()(AccRef acc, const Unit& u, int wr, int wc, int fr, int fq) const {
        const int row0 = u.pm * BM + wr * 64 + fr, col0 = u.pn * BM + wc * 32 + 8 * fq;
        f32x4 cs[2][2];
#pragma unroll
        for (int bj = 0; bj < 2; ++bj)
#pragma unroll
            for (int n = 0; n < 2; ++n) { cs[bj][n] = colscale ? *(const f32x4*)(colscale + col0 + bj * HALF + 4 * n) : (f32x4){1.f, 1.f, 1.f, 1.f}; cs[bj][n] = cs[bj][n] * scale; }
#pragma unroll
        for (int ai = 0; ai < 2; ++ai)
#pragma unroll
            for (int m = 0; m < 4; ++m) { bf16_t* rowp = O + (size_t)(row0 + ai * HALF + m * 16) * ldc + col0;
#pragma unroll
                for (int bj = 0; bj < 2; ++bj) { const f32x4 v0 = acc[ai][bj][m][0] * cs[bj][0], v1 = acc[ai][bj][m][1] * cs[bj][1];
                    u32x4 w; w.x = cvt_pk_bf16(v0[0], v0[1]); w.y = cvt_pk_bf16(v0[2], v0[3]); w.z = cvt_pk_bf16(v1[0], v1[1]); w.w = cvt_pk_bf16(v1[2], v1[3]);
                    *(u32x4*)(rowp + bj * HALF) = w; } }
    }
};

struct EpiWin {
    static constexpr bool PERM = true;
    bf16_t* Hb; float* LF; const float* lbv;
    __device__ __forceinline__ void operator()(AccRef acc, const Unit& u, int wr, int wc, int fr, int fq) const {
        const int row0 = u.pm * BM + wr * 64 + fr, cw = wc * 32 + 8 * fq, pn = u.pn;
        if (pn >= 8) {
#pragma unroll
            for (int ai = 0; ai < 2; ++ai)
#pragma unroll
                for (int m = 0; m < 4; ++m) { bf16_t* rowp = Hb + (size_t)(row0 + ai * HALF + m * 16) * HBW + 2048 + (pn - 8) * 128 + cw;
                    f32x4 r0, r1;
#pragma unroll
                    for (int e = 0; e < 4; ++e) { r0[e] = acc[ai][0][m][0][e] * sigmoidf_(acc[ai][1][m][0][e]); r1[e] = acc[ai][0][m][1][e] * sigmoidf_(acc[ai][1][m][1][e]); }
                    u32x4 w; w.x = cvt_pk_bf16(r0[0], r0[1]); w.y = cvt_pk_bf16(r0[2], r0[3]); w.z = cvt_pk_bf16(r1[0], r1[1]); w.w = cvt_pk_bf16(r1[2], r1[3]);
                    *(u32x4*)rowp = w; }
        } else if (pn == 2 || pn == 3) {
#pragma unroll
            for (int bj = 0; bj < 2; ++bj) { const int j0 = (pn - 2) * 256 + bj * HALF + cw;
                const f32x4 lb0 = *(const f32x4*)(lbv + j0), lb1 = *(const f32x4*)(lbv + j0 + 4);
#pragma unroll
                for (int ai = 0; ai < 2; ++ai)
#pragma unroll
                    for (int m = 0; m < 4; ++m) { const size_t row = (size_t)(row0 + ai * HALF + m * 16);
                        f32x4 l0, l1, k0, k1;
#pragma unroll
                        for (int e = 0; e < 4; ++e) {
                            { float x = acc[ai][bj][m][0][e]; x = fminf(fmaxf(x, -30.f), 30.f); const float ex = __expf(-x), rc = __builtin_amdgcn_rcpf(1.0f + ex), lb = lb0[e];
                              l0[e] = __logf(lb + (1.0f - lb) * rc); k0[e] = (1.0f - lb) * ex * rc; }
                            { float x = acc[ai][bj][m][1][e]; x = fminf(fmaxf(x, -30.f), 30.f); const float ex = __expf(-x), rc = __builtin_amdgcn_rcpf(1.0f + ex), lb = lb1[e];
                              l1[e] = __logf(lb + (1.0f - lb) * rc); k1[e] = (1.0f - lb) * ex * rc; } }
                        *(f32x4*)(LF + row * 512 + j0) = l0; *(f32x4*)(LF + row * 512 + j0 + 4) = l1;
                        u32x4 w; w.x = cvt_pk_bf16(k0[0], k0[1]); w.y = cvt_pk_bf16(k0[2], k0[3]); w.z = cvt_pk_bf16(k1[0], k1[1]); w.w = cvt_pk_bf16(k1[2], k1[3]);
                        *(u32x4*)(Hb + row * HBW + 512 + j0) = w; } }
        } else {
            const bool act = pn >= 6;
#pragma unroll
            for (int ai = 0; ai < 2; ++ai)
#pragma unroll
                for (int m = 0; m < 4; ++m) { bf16_t* rowp = Hb + (size_t)(row0 + ai * HALF + m * 16) * HBW + pn * 256 + cw;
#pragma unroll
                    for (int bj = 0; bj < 2; ++bj) { f32x4 v0 = acc[ai][bj][m][0], v1 = acc[ai][bj][m][1];
                        if (act) {
#pragma unroll
                            for (int e = 0; e < 4; ++e) { v0[e] = siluf_(v0[e]); v1[e] = siluf_(v1[e]); } }
                        u32x4 w; w.x = cvt_pk_bf16(v0[0], v0[1]); w.y = cvt_pk_bf16(v0[2], v0[3]); w.z = cvt_pk_bf16(v1[0], v1[1]); w.w = cvt_pk_bf16(v1[2], v1[3]);
                        *(u32x4*)(rowp + bj * HALF) = w; } }
        }
    }
};

struct EpiSwiGLU {
    static constexpr bool PERM = true;
    bf16_t* H; int ldc;
    __device__ __forceinline__ void operator()(AccRef acc, const Unit& u, int wr, int wc, int fr, int fq) const {
        const int row0 = u.pm * BM + wr * 64 + fr, col0 = u.pn * HALF + wc * 32 + 8 * fq;
#pragma unroll
        for (int ai = 0; ai < 2; ++ai)
#pragma unroll
            for (int m = 0; m < 4; ++m) { bf16_t* rowp = H + (size_t)(row0 + ai * HALF + m * 16) * ldc + col0;
                f32x4 r0, r1;
#pragma unroll
                for (int e = 0; e < 4; ++e) { r0[e] = siluf_(acc[ai][0][m][0][e]) * acc[ai][1][m][0][e]; r1[e] = siluf_(acc[ai][0][m][1][e]) * acc[ai][1][m][1][e]; }
                u32x4 w; w.x = cvt_pk_bf16(r0[0], r0[1]); w.y = cvt_pk_bf16(r0[2], r0[3]); w.z = cvt_pk_bf16(r1[0], r1[1]); w.w = cvt_pk_bf16(r1[2], r1[3]);
                *(u32x4*)rowp = w; }
    }
};

struct EpiSoftmax {
    static constexpr bool PERM = true;
    LAS float* X;
    __device__ __forceinline__ void operator()(AccRef acc, const Unit& u, int wr, int wc, int fr, int fq) const {
#pragma unroll
        for (int ai = 0; ai < 2; ++ai)
#pragma unroll
            for (int m = 0; m < 4; ++m) {
                float mx = -3.0e38f;
#pragma unroll
                for (int bj = 0; bj < 2; ++bj)
#pragma unroll
                    for (int n = 0; n < 2; ++n) { const f32x4 v = acc[ai][bj][m][n]; mx = fmaxf(mx, fmaxf(fmaxf(v[0], v[1]), fmaxf(v[2], v[3]))); }
                mx = fmaxf(mx, __shfl_xor(mx, 16)); mx = fmaxf(mx, __shfl_xor(mx, 32));
                float s = 0.f;
#pragma unroll
                for (int bj = 0; bj < 2; ++bj)
#pragma unroll
                    for (int n = 0; n < 2; ++n) { const f32x4 v = acc[ai][bj][m][n]; s += (__expf(v[0] - mx) + __expf(v[1] - mx)) + (__expf(v[2] - mx) + __expf(v[3] - mx)); }
                s += __shfl_xor(s, 16); s += __shfl_xor(s, 32);
                if (fq == 0) *(LAS f32x2*)(X + (ai * HALF + wr * 64 + m * 16 + fr) * 8 + wc * 2) = (f32x2){mx, s};
                __builtin_amdgcn_sched_barrier(0);
            }
        LDS_WAIT(); __builtin_amdgcn_s_barrier(); asm volatile("" ::: "memory");
        const int col0 = u.pn * BM + wc * 32 + 8 * fq;
#pragma unroll
        for (int ai = 0; ai < 2; ++ai)
#pragma unroll
            for (int m = 0; m < 4; ++m) { const int r = ai * HALF + wr * 64 + m * 16 + fr;
                const f32x4 a = *(const LAS f32x4*)(X + r * 8), b = *(const LAS f32x4*)(X + r * 8 + 4);
                const float M = fmaxf(fmaxf(a[0], a[2]), fmaxf(b[0], b[2]));
                const float ssum = (a[1] * __expf(a[0] - M) + a[3] * __expf(a[2] - M)) + (b[1] * __expf(b[0] - M) + b[3] * __expf(b[2] - M));
                const float inv = __builtin_amdgcn_rcpf(ssum);
                bf16_t* rowp = ((bf16_t*)WSP(WS_R1) + (size_t)MROWS * DM) + (size_t)(u.pm * BM + r) * DM + col0;
#pragma unroll
                for (int bj = 0; bj < 2; ++bj) { f32x4 v0 = acc[ai][bj][m][0], v1 = acc[ai][bj][m][1];
#pragma unroll
                    for (int e = 0; e < 4; ++e) { v0[e] = __expf(v0[e] - M) * inv; v1[e] = __expf(v1[e] - M) * inv; }
                    u32x4 w; w.x = cvt_pk_bf16(v0[0], v0[1]); w.y = cvt_pk_bf16(v0[2], v0[3]); w.z = cvt_pk_bf16(v1[0], v1[1]); w.w = cvt_pk_bf16(v1[2], v1[3]);
                    *(u32x4*)(rowp + bj * HALF) = w; }
                __builtin_amdgcn_sched_barrier(0); }
    }
};
}


#define XB_TMO      128
#define XB_XCNT(j)  (256  + 64 * (j))
#define XB_XSUB(j)  (1280 + 64 * (j))
#define XB_XGEN(j)  (2304 + 64 * (j))
#define XB_TOP      3328
#define XB_TOPGEN   3392
#define XCD_BAR_WORDS 3456
#define XB_SPIN_CAP (1u << 18)
__device__ __forceinline__ unsigned xb_ld(unsigned* p)              { return __hip_atomic_load(p, __ATOMIC_RELAXED, __HIP_MEMORY_SCOPE_AGENT); }
__device__ __forceinline__ unsigned xb_add(unsigned* p, unsigned v) { return __hip_atomic_fetch_add(p, v, __ATOMIC_RELAXED, __HIP_MEMORY_SCOPE_AGENT); }
__device__ __forceinline__ unsigned xb_xcc_id() { return (unsigned)__builtin_amdgcn_s_getreg((3 << 11) | 20) & 0xFu; }
#define XB_SPIN(cond, bar) do { unsigned _sp = 0; while (cond) { __builtin_amdgcn_s_sleep(1); \
    if ((++_sp & 255u) == 0u) { if (xb_ld(&(bar)[XB_TMO])) break; if (_sp > XB_SPIN_CAP) { atomicAdd(&(bar)[XB_TMO], 1u); break; } } } } while (0)
struct XcdBarrier { unsigned* bar; unsigned x; volatile LAS unsigned* st; };
__device__ __forceinline__ XcdBarrier xcd_barrier_post(unsigned* bar, volatile LAS unsigned* st) {
    XcdBarrier b; b.bar = bar; b.x = xb_xcc_id(); b.st = st;
    if (threadIdx.x == 0) (void)xb_add(&bar[XB_XCNT(b.x)], 1u);
    return b;
}
__device__ __forceinline__ void xcd_barrier_complete(unsigned* bar, unsigned x, unsigned& nloc, unsigned& nx) {
    const unsigned G = gridDim.x * gridDim.y * gridDim.z;
    unsigned sum, cnt, mine, sp = 0u;
    for (;;) {
        sum = 0u; cnt = 0u; mine = 0u;
#pragma unroll
        for (unsigned j = 0; j < 16; ++j) { const unsigned c = xb_ld(&bar[XB_XCNT(j)]); sum += c; cnt += (c > 0u) ? 1u : 0u; mine = (j == x) ? c : mine; }
        if (sum == G) break;
        __builtin_amdgcn_s_sleep(1);
        if ((++sp & 255u) == 0u) { if (xb_ld(&bar[XB_TMO])) break; if (sp > XB_SPIN_CAP) { atomicAdd(&bar[XB_TMO], 1u); break; } }
    }
    nloc = mine > 0u ? mine : 1u; nx = cnt > 0u ? cnt : 1u;
}
__device__ __forceinline__ void xcd_barrier(const XcdBarrier& b) {
    asm volatile("s_waitcnt vmcnt(0)" ::: "memory");
    __syncthreads();
    if (threadIdx.x == 0) {
        unsigned* bar = b.bar;
        __builtin_amdgcn_s_waitcnt(0);
        unsigned nloc = b.st[0], nx = b.st[1];
        if (nloc == 0u) { xcd_barrier_complete(bar, b.x, nloc, nx); b.st[0] = nloc; b.st[1] = nx; }
        const unsigned old = xb_add(&bar[XB_XSUB(b.x)], 1u);
        const unsigned gen = old / nloc;
        if (old + 1u == (gen + 1u) * nloc) {
            __builtin_amdgcn_fence(__ATOMIC_RELEASE, "agent");
            asm volatile("s_waitcnt vmcnt(0)" ::: "memory");
            const unsigned og = xb_add(&bar[XB_TOP], 1u);
            const unsigned tg = og / nx;
            if (og + 1u == (tg + 1u) * nx) xb_add(&bar[XB_TOPGEN], 1u);
            else XB_SPIN(xb_ld(&bar[XB_TOPGEN]) == tg, bar);
            __builtin_amdgcn_fence(__ATOMIC_ACQUIRE, "agent");
            xb_add(&bar[XB_XGEN(b.x)], 1u);
            asm volatile("s_waitcnt vmcnt(0)" ::: "memory");
        } else {
            XB_SPIN(xb_ld(&bar[XB_XGEN(b.x)]) == gen, bar);
            __builtin_amdgcn_fence(__ATOMIC_ACQUIRE, "agent");
            asm volatile("s_waitcnt vmcnt(0)" ::: "memory");
        }
    }
    __syncthreads();
}

__device__ __forceinline__ void transpose_item(const float* W, int ldw, bf16_t* WT, int ldt, int k0, int n0, int drow0, LAS float* scr, int lane) {
#pragma unroll 8
    for (int i = 0; i < 32; ++i) { const int kk = 2 * i + (lane >> 5); scr[kk * 33 + (lane & 31)] = __builtin_nontemporal_load(W + (size_t)(k0 + kk) * ldw + n0 + (lane & 31)); }
    LDS_WAIT();
    const int c = lane & 7;
#pragma unroll
    for (int j = 0; j < 4; ++j) { const int n = (lane >> 3) + 8 * j; const LAS float* s = scr + (8 * c) * 33 + n;
        u32x4 o; o.x = cvt_pk_bf16(s[0 * 33], s[1 * 33]); o.y = cvt_pk_bf16(s[2 * 33], s[3 * 33]); o.z = cvt_pk_bf16(s[4 * 33], s[5 * 33]); o.w = cvt_pk_bf16(s[6 * 33], s[7 * 33]);
        *(u32x4*)(WT + (size_t)(drow0 + n) * ldt + k0 + 8 * c) = o; }
    LDS_WAIT();
}
__device__ __forceinline__ int map_win(int n0) { return n0 < 2048 ? n0 : (n0 < 2560 ? 2048 + ((n0 - 2048) >> 7) * 256 + ((n0 - 2048) & 127) : 2048 + ((n0 - 2560) >> 7) * 256 + 128 + ((n0 - 2560) & 127)); }
__device__ __forceinline__ int map_gate(int n0) { return (n0 >> 7) * 256 + (n0 & 127); }
__device__ __forceinline__ int map_up(int n0) { return (n0 >> 7) * 256 + 128 + (n0 & 127); }

__device__ __forceinline__ void ln_row(const float* zrow, const bf16_t* zbrow, const bf16_t* yrow, float* xrow, bf16_t* brow, const f32x4 (&gv)[4], const f32x4 (&bv)[4], int lane) {
    f32x4 v[4]; float s = 0.f;
#pragma unroll
    for (int j = 0; j < 4; ++j) {
        if (zbrow) { const u32x2 zb = *(const u32x2*)(zbrow + 4 * lane + 256 * j); v[j] = (f32x4){bflo(zb.x), bfhi(zb.x), bflo(zb.y), bfhi(zb.y)}; }
        else v[j] = *(const f32x4*)(zrow + 4 * lane + 256 * j);
        if (yrow) { const u32x2 y = __builtin_nontemporal_load((const u32x2*)(yrow + 4 * lane + 256 * j)); v[j] = v[j] * ALPHA + (f32x4){bflo(y.x), bfhi(y.x), bflo(y.y), bfhi(y.y)}; }
        s += (v[j][0] + v[j][1]) + (v[j][2] + v[j][3]); }
    const float mean = wave_sum(s) * (1.f / DM); float s2 = 0.f;
#pragma unroll
    for (int j = 0; j < 4; ++j) { v[j] = v[j] - mean; s2 += (v[j][0] * v[j][0] + v[j][1] * v[j][1]) + (v[j][2] * v[j][2] + v[j][3] * v[j][3]); }
    const float rstd = 1.0f / sqrtf(wave_sum(s2) * (1.f / DM) + LN_EPS);
#pragma unroll
    for (int j = 0; j < 4; ++j) { const f32x4 y = v[j] * rstd * gv[j] + bv[j];
        if (xrow) __builtin_nontemporal_store(y, (f32x4*)(xrow + 4 * lane + 256 * j));
        if (brow) { u32x2 w; w.x = cvt_pk_bf16(y[0], y[1]); w.y = cvt_pk_bf16(y[2], y[3]); *(u32x2*)(brow + 4 * lane + 256 * j) = w; } }
}
__device__ __forceinline__ void ln_pass(const float* Z, const bf16_t* Zb, const bf16_t* Y, float* Xf, bf16_t* Xb_, const float* g, const float* b, int rows, int gw, int NGW, int lane) {
    f32x4 gv[4], bv[4];
#pragma unroll
    for (int j = 0; j < 4; ++j) { gv[j] = *(const f32x4*)(g + 4 * lane + 256 * j); bv[j] = *(const f32x4*)(b + 4 * lane + 256 * j); }
    for (int r = gw; r < rows; r += NGW) ln_row(Z ? Z + (size_t)r * DM : nullptr, Zb ? Zb + (size_t)r * DM : nullptr, Y ? Y + (size_t)r * DM : nullptr, Xf ? Xf + (size_t)r * DM : nullptr, Xb_ ? Xb_ + (size_t)r * DM : nullptr, gv, bv, lane);
}

template <bool OUT>
__device__ __forceinline__ void hgrn_unit(LAS unsigned char* lds, int unit, const bf16_t* Hb, const float* LF, float* SLOC, float* SDEC, const float* hg_g, bf16_t* Y, int tid, int wid, int lane) {
    const int b = unit >> 6, h = (unit >> 4) & 3, seg = unit & 15;
    const int d = tid & 127, tq = tid >> 7, r = lane & 15, g = lane >> 4;
    LAS unsigned char* QT = lds; LAS unsigned char* KT = lds + 8704; LAS unsigned char* KET = lds + 17408; LAS unsigned char* VT = lds + 27648;
    LAS float* DEC = (LAS float*)(lds + 37888); LAS float* TOT = (LAS float*)(lds + 38400); LAS float* OL = (LAS float*)(lds + 40448);
    LAS unsigned char* ST = lds + 57344 + wid * 4352; LAS unsigned char* PP = lds + 92160 + wid * 2560;
    f32x4 accS[8];
    float* sl = SLOC + (size_t)unit * 16384 + wid * 2048 + lane;
    if (OUT) {
#pragma unroll
        for (int di = 0; di < 8; ++di) {
#pragma unroll
            for (int i = 0; i < 4; ++i) accS[di][i] = sl[(di * 4 + i) * 64];
            u32x2 w; w.x = cvt_pk_bf16(accS[di][0], accS[di][1]); w.y = cvt_pk_bf16(accS[di][2], accS[di][3]);
            *(LAS u32x2*)(ST + r * 272 + (16 * di + 4 * g) * 2) = w; }
    } else {
#pragma unroll
        for (int di = 0; di < 8; ++di) accS[di] = (f32x4){0.f, 0.f, 0.f, 0.f};
    }
    float bsum = 0.f;
    const size_t tok0 = (size_t)b * SEQ + (size_t)seg * 512;
    for (int c = 0; c < 16; ++c) {
        const size_t t0 = tok0 + c * 32 + tq * 8;
        float lf[8]; unsigned short kk[8], vv[8], qq[8];
#pragma unroll
        for (int i = 0; i < 8; ++i) { lf[i] = LF[(t0 + i) * 512 + h * 128 + d]; kk[i] = Hb[(t0 + i) * HBW + 512 + h * 128 + d]; vv[i] = Hb[(t0 + i) * HBW + 1024 + h * 128 + d];
            if (OUT) qq[i] = Hb[(t0 + i) * HBW + h * 128 + d]; }
#pragma unroll
        for (int i = 1; i < 8; ++i) lf[i] += lf[i - 1];
        TOT[tq * 128 + d] = lf[7];
        __syncthreads();
        float off = 0.f, blast = 0.f;
#pragma unroll
        for (int j = 0; j < 4; ++j) { const float tj = TOT[j * 128 + d]; blast += tj; if (j < tq) off += tj; }
        float ke[8];
#pragma unroll
        for (int i = 0; i < 8; ++i) { const float bi = off + lf[i], kf = bf2f(kk[i]);
            ke[i] = kf * __expf(blast - bi);
            if (OUT) { const unsigned qv = cvt_pk_bf16(bf2f(qq[i]) * __expf(bi), kf * __expf(-bi));
                *(LAS unsigned short*)(QT + (8 * tq + i) * 272 + d * 2) = (unsigned short)(qv & 0xffffu);
                *(LAS unsigned short*)(KT + (8 * tq + i) * 272 + d * 2) = (unsigned short)(qv >> 16); } }
        { u32x4 w; w.x = cvt_pk_bf16(ke[0], ke[1]); w.y = cvt_pk_bf16(ke[2], ke[3]); w.z = cvt_pk_bf16(ke[4], ke[5]); w.w = cvt_pk_bf16(ke[6], ke[7]);
          *(LAS u32x4*)(KET + d * 80 + 16 * tq) = w;
          u32x4 x; x.x = (unsigned)vv[0] | ((unsigned)vv[1] << 16); x.y = (unsigned)vv[2] | ((unsigned)vv[3] << 16); x.z = (unsigned)vv[4] | ((unsigned)vv[5] << 16); x.w = (unsigned)vv[6] | ((unsigned)vv[7] << 16);
          *(LAS u32x4*)(VT + d * 80 + 16 * tq) = x; }
        if (tq == 0) { DEC[d] = __expf(blast); bsum += blast; }
        __syncthreads();
        u32x4 sgp; f32x4 g0p, g1p;
        if (OUT) { const int t_ = tid >> 4, v0_ = (tid & 15) * 8; sgp = *(const u32x4*)(Hb + (tok0 + c * 32 + t_) * HBW + 1536 + h * 128 + v0_);
            g0p = *(const f32x4*)(hg_g + h * 128 + v0_); g1p = *(const f32x4*)(hg_g + h * 128 + v0_ + 4); }
        const bf16x8 bv = *(const LAS bf16x8*)(VT + (16 * wid + r) * 80 + 16 * g);
        if (OUT) {
#pragma unroll
            for (int ti = 0; ti < 2; ++ti)
#pragma unroll
                for (int si = 0; si < 2; ++si) {
                    f32x4 sc = (f32x4){0.f, 0.f, 0.f, 0.f};
                    if (si <= ti) {
#pragma unroll
                        for (int k4 = 0; k4 < 4; ++k4) { const bf16x8 a = *(const LAS bf16x8*)(KT + (16 * si + r) * 272 + 64 * k4 + 16 * g), q = *(const LAS bf16x8*)(QT + (16 * ti + r) * 272 + 64 * k4 + 16 * g);
                            sc = __builtin_amdgcn_mfma_f32_16x16x32_bf16(a, q, sc, 0, 0, 0); }
                        if (si == ti) {
#pragma unroll
                            for (int i = 0; i < 4; ++i) if (4 * g + i > r) sc[i] = 0.f; }
                    }
                    u32x2 w; w.x = cvt_pk_bf16(sc[0], sc[1]); w.y = cvt_pk_bf16(sc[2], sc[3]);
                    *(LAS u32x2*)(PP + (16 * ti + r) * 80 + (16 * si + 4 * g) * 2) = w;
                }
            LDS_WAIT();
#pragma unroll
            for (int ti = 0; ti < 2; ++ti) {
                f32x4 o = (f32x4){0.f, 0.f, 0.f, 0.f};
                { const bf16x8 a = *(const LAS bf16x8*)(PP + (16 * ti + r) * 80 + 16 * g); o = __builtin_amdgcn_mfma_f32_16x16x32_bf16(a, bv, o, 0, 0, 0); }
#pragma unroll
                for (int k4 = 0; k4 < 4; ++k4) { const bf16x8 a = *(const LAS bf16x8*)(QT + (16 * ti + r) * 272 + 64 * k4 + 16 * g), s = *(const LAS bf16x8*)(ST + r * 272 + 64 * k4 + 16 * g);
                    o = __builtin_amdgcn_mfma_f32_16x16x32_bf16(a, s, o, 0, 0, 0); }
#pragma unroll
                for (int i = 0; i < 4; ++i) OL[(16 * ti + 4 * g + i) * 132 + 16 * wid + r] = o[i];
            }
            LDS_WAIT();
        }
#pragma unroll
        for (int di = 0; di < 8; ++di) { const f32x4 dec = *(const LAS f32x4*)(DEC + 16 * di + 4 * g); const bf16x8 a = *(const LAS bf16x8*)(KET + (16 * di + r) * 80 + 16 * g);
            accS[di] = accS[di] * dec; accS[di] = __builtin_amdgcn_mfma_f32_16x16x32_bf16(a, bv, accS[di], 0, 0, 0); }
        if (OUT) {
#pragma unroll
            for (int di = 0; di < 8; ++di) { u32x2 w; w.x = cvt_pk_bf16(accS[di][0], accS[di][1]); w.y = cvt_pk_bf16(accS[di][2], accS[di][3]);
                *(LAS u32x2*)(ST + r * 272 + (16 * di + 4 * g) * 2) = w; }
            __syncthreads();
            const int t = tid >> 4, v0 = (tid & 15) * 8; const size_t tok = tok0 + c * 32 + t;
            const f32x4 o0 = *(const LAS f32x4*)(OL + t * 132 + v0), o1 = *(const LAS f32x4*)(OL + t * 132 + v0 + 4);
            float ss = (o0[0] * o0[0] + o0[1] * o0[1]) + (o0[2] * o0[2] + o0[3] * o0[3]) + (o1[0] * o1[0] + o1[1] * o1[1]) + (o1[2] * o1[2] + o1[3] * o1[3]);
            ss += __shfl_xor(ss, 1); ss += __shfl_xor(ss, 2); ss += __shfl_xor(ss, 4); ss += __shfl_xor(ss, 8);
            const float rms = 1.0f / sqrtf(ss * (1.f / 128.f) + RMS_EPS);
            const f32x4 g0 = g0p, g1 = g1p; const u32x4 sg = sgp;
            u32x4 w;
            w.x = cvt_pk_bf16(o0[0] * rms * g0[0] * bflo(sg.x), o0[1] * rms * g0[1] * bfhi(sg.x));
            w.y = cvt_pk_bf16(o0[2] * rms * g0[2] * bflo(sg.y), o0[3] * rms * g0[3] * bfhi(sg.y));
            w.z = cvt_pk_bf16(o1[0] * rms * g1[0] * bflo(sg.z), o1[1] * rms * g1[1] * bfhi(sg.z));
            w.w = cvt_pk_bf16(o1[2] * rms * g1[2] * bflo(sg.w), o1[3] * rms * g1[3] * bfhi(sg.w));
            *(u32x4*)(Y + tok * DM + h * 128 + v0) = w;
        }
    }
    if (!OUT) {
#pragma unroll
        for (int di = 0; di < 8; ++di)
#pragma unroll
            for (int i = 0; i < 4; ++i) sl[(di * 4 + i) * 64] = accS[di][i];
        if (tq == 0) SDEC[unit * 128 + d] = __expf(bsum);
    }
    __syncthreads();
}

__device__ __forceinline__ void conv_tile(LAS unsigned char* lds, int tile, const bf16_t* Hb, const float (&w)[31], float cb, const float* lng, const float* lnb, bf16_t* Y, int tid, int wid, int lane) {
    const int t0 = tile * 16, pos0 = t0 & (SEQ - 1), c = tid;
    float acc[16];
#pragma unroll
    for (int o = 0; o < 16; ++o) acc[o] = cb;
#pragma unroll
    for (int jj = 0; jj < 46; ++jj) {
        const int tt = pos0 - 30 + jj;
        const float val = bf2f(Hb[(size_t)(t0 - 30 + jj + (tt >= 0 ? 0 : -tt)) * HBW + 2048 + c]) * (tt >= 0 ? 1.f : 0.f);
#pragma unroll
        for (int o = 0; o < 16; ++o) { const int j = jj - o; if (j >= 0 && j <= 30) acc[o] += w[j] * val; }
    }
    LAS float* CL = (LAS float*)lds;
#pragma unroll
    for (int o = 0; o < 16; ++o) CL[o * 512 + c] = acc[o];
    __syncthreads();
#pragma unroll
    for (int oo = 0; oo < 2; ++oo) { const int o = 2 * wid + oo;
        f32x4 v[2]; float s = 0.f;
#pragma unroll
        for (int j = 0; j < 2; ++j) { v[j] = *(const LAS f32x4*)(CL + o * 512 + 4 * lane + 256 * j); s += (v[j][0] + v[j][1]) + (v[j][2] + v[j][3]); }
        const float mean = wave_sum(s) * (1.f / 512.f); float s2 = 0.f;
#pragma unroll
        for (int j = 0; j < 2; ++j) { v[j] = v[j] - mean; s2 += (v[j][0] * v[j][0] + v[j][1] * v[j][1]) + (v[j][2] * v[j][2] + v[j][3] * v[j][3]); }
        const float rstd = 1.0f / sqrtf(wave_sum(s2) * (1.f / 512.f) + LN_EPS);
#pragma unroll
        for (int j = 0; j < 2; ++j) { const f32x4 gg = *(const f32x4*)(lng + 4 * lane + 256 * j), bb = *(const f32x4*)(lnb + 4 * lane + 256 * j); f32x4 y = v[j] * rstd * gg + bb;
#pragma unroll
            for (int e = 0; e < 4; ++e) y[e] = siluf_(y[e]);
            u32x2 wv; wv.x = cvt_pk_bf16(y[0], y[1]); wv.y = cvt_pk_bf16(y[2], y[3]);
            *(u32x2*)(Y + (size_t)(t0 + o) * DM + 512 + 4 * lane + 256 * j) = wv; }
    }
    __syncthreads();
}

template <int W>
__device__ __forceinline__ void pool_tile(int tile, const bf16_t* Xr, bf16_t* Pp, int tid) {
    const int t0 = tile * 16, pos0 = t0 & (SEQ - 1), c = 2 * tid;
    f32x2 xs[15 + W];
#pragma unroll
    for (int k = 0; k < 15 + W; ++k) { const int tt = pos0 - (W - 1) + k;
        const unsigned v = *(const unsigned*)(Xr + (size_t)(t0 - (W - 1) + k + (tt >= 0 ? 0 : -tt)) * DM + c); const float msk = tt >= 0 ? 1.f : 0.f; xs[k] = (f32x2){bflo(v) * msk, bfhi(v) * msk}; }
#pragma unroll
    for (int o = 0; o < 16; ++o) {
        f32x2 s = xs[o + W - 1];
#pragma unroll
        for (int i = 1; i < W; ++i) s += xs[o + W - 1 - i];
        const int pos = pos0 + o; const float inv = 1.0f / (float)(pos + 1 < W ? pos + 1 : W);
        const f32x2 p = s * inv - xs[o + W - 1];
        *(unsigned*)(Pp + (size_t)(t0 + o) * DM + c) = cvt_pk_bf16(p[0], p[1]);
    }
}

#define x_in AIN(0)
#define Win_t ((bf16_t*)WSP(WS_WIN))
#define Wout_t ((bf16_t*)WSP(WS_WOUT))
#define Wk_t ((bf16_t*)WSP(WS_WK))
#define Wv_t ((bf16_t*)WSP(WS_WV))
#define Wo_t ((bf16_t*)WSP(WS_WO))
#define Wgu_t ((bf16_t*)WSP(WS_WGU))
#define Wd_t ((bf16_t*)WSP(WS_WD))
#define Wpool_t ((bf16_t*)WSP(WS_WPOOL))
#define Memn ((bf16_t*)WSP(WS_MEMN))
#define Kmat ((bf16_t*)WSP(WS_KMAT))
#define Vmat ((bf16_t*)WSP(WS_VT))
#define Abt ((bf16_t*)WSP(WS_ABT))
#define Cbt ((bf16_t*)WSP(WS_CBT))
#define Wq_n ((bf16_t*)WSP(WS_WQ))
#define lbv ((float*)WSP(WS_LBV))
#define SDEC ((float*)WSP(WS_SDEC))
#define SLOC ((float*)WSP(WS_SLOC))
#define SST ((float*)WSP(WS_SST))
#define Xb ((bf16_t*)WSP(WS_XB))
#define LF ((float*)WSP(WS_LF))
#define Ybuf ((bf16_t*)WSP(WS_LF))
#define Hb ((bf16_t*)WSP(WS_R1))
#define Hff ((bf16_t*)WSP(WS_R1))
#define Pb ((bf16_t*)WSP(WS_R1) + (size_t)MROWS * DM)
#define Yb ((bf16_t*)WSP(WS_R3))
#define Pp ((bf16_t*)WSP(WS_R3))
#define out ((float*)get_args()->out)

#define lane lane_id_v()
#define tid (wid * 64 + lane_id_v())

constexpr int C_WIN = 16 * 96, C_SQ = 16 * 32, C_GU = 16 * 88, C_WD = 44 * 32, C_POOL = 4 * 8;
constexpr int C_LAYER = 4 * C_SQ + 2 * C_GU + C_WD;
constexpr int NITEMS = C_WIN + C_SQ + 2 * C_LAYER + 4 * C_POOL;
__device__ __forceinline__ void weight_item(int it, bool late, LAS float* scr, int lane_) {
    int r = it;
    if (r < C_WIN) { if (late) return; const int kb = r / 96, n0 = (r % 96) * 32; transpose_item(AIN(5), INCOLS, Win_t, DM, kb * 64, n0, map_win(n0), scr, lane_); return; }
    r -= C_WIN;
    if (r < C_SQ) { if (late) return; const int kb = r / 32, n0 = (r % 32) * 32; transpose_item(AIN(11), DM, Wout_t, DM, kb * 64, n0, n0, scr, lane_); return; }
    r -= C_SQ;
    if (r < 2 * C_LAYER) {
        const int l = r / C_LAYER; r -= l * C_LAYER;
        if (r < 4 * C_SQ) { const int q = r / C_SQ; r -= q * C_SQ; const int kb = r / 32, n0 = (r % 32) * 32;
            if (q == 0) return;
            if ((q == 3) != late) return;
            const float* src = AIN(16 + q) + (size_t)l * DM * DM; bf16_t* dst = (q == 1 ? Wk_t : q == 2 ? Wv_t : Wo_t) + (size_t)l * DM * DM;
            transpose_item(src, DM, dst, DM, kb * 64, n0, n0, scr, lane_); return; }
        if (!late) return;
        r -= 4 * C_SQ;
        if (r < 2 * C_GU) { const int q = r / C_GU; r -= q * C_GU; const int kb = r / 88, n0 = (r % 88) * 32;
            transpose_item(AIN(22 + q) + (size_t)l * DM * FF, FF, Wgu_t + (size_t)l * 2 * FF * DM, DM, kb * 64, n0, q == 0 ? map_gate(n0) : map_up(n0), scr, lane_); return; }
        r -= 2 * C_GU;
        { const int kb = r / 32, n0 = (r % 32) * 32; transpose_item(AIN(24) + (size_t)l * FF * DM, DM, Wd_t + (size_t)l * DM * FF, FF, kb * 64, n0, n0, scr, lane_); return; }
    }
    if (!late) return;
    r -= 2 * C_LAYER;
    { const int gi = r / C_POOL, rr = r % C_POOL, kb = rr / 8, n0 = (rr % 8) * 32; transpose_item(AIN(12) + (size_t)gi * 65536, 256, Wpool_t, 256, kb * 64, n0, gi * 256 + n0, scr, lane_); }
}

#define GSYNC() xcd_barrier(xbar)
template <int l>
__device__ __forceinline__ void layer_body(LAS unsigned char* lds, const XcdBarrier& xbar, int wid, int G, int bid, int gw, int NGW) {
        if (l == 1) {
            for (int t = bid; t < MROWS / 16; t += G) {
                if (wid < 2) pool_tile<2>(t, Xb, Pp, tid); else if (wid < 4) pool_tile<4>(t, Xb, Pp, tid); else if (wid < 6) pool_tile<8>(t, Xb, Pp, tid); else pool_tile<16>(t, Xb, Pp, tid);
            }
            GSYNC();
            { pg8::Gemm g = pg8::mk_gemm(Pp, Wpool_t, DM, 256, 256); g.a_pn_off = 256; pg8::Order S; S.init(MROWS / 256, 4, G, bid);
              pg8::EpiStoreBf16 E{Ybuf, DM, 1.0f, AIN(13)}; pg8::gemm_phase(lds, g, S, E, wid); }
            GSYNC();
            ln_pass(nullptr, Xb, Ybuf, nullptr, Xb, AIN(14) + DM, AIN(15) + DM, MROWS, gw, NGW, lane);
            GSYNC();
        }
        { pg8::Gemm g = pg8::mk_gemm(Xb, Abt + (size_t)l * 4096 * DM, DM, DM, DM); g.b_sh = 5; g.b_hi = (long)DM * DM;
          pg8::Order S; S.init(MROWS / 256, 4, G, bid);
          pg8::EpiSoftmax E{(LAS float*)(lds + XCH_OFF)}; pg8::gemm_phase(lds, g, S, E, wid); }
        GSYNC();
        { pg8::Gemm g = pg8::mk_gemm(Pb, Cbt + (size_t)l * 4096 * DM, DM, DM, DM); g.b_sh = 5; g.b_hi = (long)DM * DM;
          pg8::Order S; S.init(MROWS / 256, 4, G, bid);
          pg8::EpiStoreBf16 E{Ybuf, DM, 1.0f, nullptr}; pg8::gemm_phase(lds, g, S, E, wid); }
        GSYNC();
        ln_pass(nullptr, Xb, Ybuf, nullptr, Xb, AIN(20) + l * DM, AIN(21) + l * DM, MROWS, gw, NGW, lane);
        GSYNC();
        { pg8::Gemm g = pg8::mk_gemm(Xb, Wgu_t + (size_t)l * 2 * FF * DM, DM, DM, DM); pg8::Order S; S.init(MROWS / 256, 2 * FF / 256, G, bid);
          pg8::EpiSwiGLU E{Hff, FF}; pg8::gemm_phase(lds, g, S, E, wid); }
        GSYNC();
        { pg8::Gemm g = pg8::mk_gemm(Hff, Wd_t + (size_t)l * DM * FF, FF, FF, FF); pg8::Order S; S.init(MROWS / 256, 4, G, bid);
          pg8::EpiStoreBf16 E{Ybuf, DM, 1.0f, nullptr}; pg8::gemm_phase(lds, g, S, E, wid); }
        GSYNC();
        ln_pass(nullptr, Xb, Ybuf, l == 1 ? out : nullptr, l == 1 ? nullptr : Xb, AIN(25) + l * DM, AIN(26) + l * DM, MROWS, gw, NGW, lane);
        if (l == 0) GSYNC();
    }

__global__ void __launch_bounds__(512, 2) fwd_megakernel(Args a_unused) {
    extern __shared__ __attribute__((aligned(16))) unsigned char lds_raw[];
    LAS unsigned char* lds = (LAS unsigned char*)lds_raw;
    cg::grid_group grid = cg::this_grid();
    const int wid = __builtin_amdgcn_readfirstlane((int)threadIdx.x >> 6);
#define lane lane_id_v()
#define tid (wid * 64 + lane_id_v())
    const int G = gridDim.x, bid = blockIdx.x, gw = bid * 8 + wid, NGW = G * 8;

    volatile LAS unsigned* xst = (volatile LAS unsigned*)(lds + XCH_OFF + 8192);
    if (tid < 2) xst[tid] = 0u;
    __syncthreads();
    const XcdBarrier xbar = xcd_barrier_post((unsigned*)WSP(WS_BAR), xst);
    if (G == 0x7fffffff) grid.sync();
    {
        LAS float* scr = (LAS float*)(lds + wid * 16384);
        for (int it = gw; it < NITEMS; it += NGW) weight_item(it, false, scr, lane);
        { const size_t n8 = (size_t)MROWS * DM / 8;
          for (size_t i = (size_t)bid * 512 + tid; i < n8; i += (size_t)G * 512) { const f32x4 v0 = __builtin_nontemporal_load((const f32x4*)(x_in + i * 8)), v1 = __builtin_nontemporal_load((const f32x4*)(x_in + i * 8 + 4));
              u32x4 w; w.x = cvt_pk_bf16(v0[0], v0[1]); w.y = cvt_pk_bf16(v0[2], v0[3]); w.z = cvt_pk_bf16(v1[0], v1[1]); w.w = cvt_pk_bf16(v1[2], v1[3]);
              *(u32x4*)(Xb + i * 8) = w; } }
        ln_pass(AIN(1), nullptr, nullptr, nullptr, Memn, AIN(3), AIN(4), MEMROWS, gw, NGW, lane);
        if (bid == 0) { const float* lp = AIN(2); const float p0 = lp[tid], p1 = lp[512 + tid], p2 = lp[1024 + tid]; const float mx = fmaxf(p0, fmaxf(p1, p2));
            const float e0 = __expf(p0 - mx), e1 = __expf(p1 - mx), e2 = __expf(p2 - mx); lbv[tid] = e0 / (e0 + e1 + e2); }
    }
    GSYNC();

    {
        pg8::Gemm g = pg8::mk_gemm(Xb, Win_t, DM, DM, DM); pg8::Order S; S.init(MROWS / 256, INCOLS / 256, G, bid);
        pg8::EpiWin E{Hb, LF, lbv};
        pg8::gemm_phase(lds, g, S, E, wid);
    }
    GSYNC();

    {
        for (int u = bid; u < 256; u += G) hgrn_unit<false>(lds, u, Hb, LF, SLOC, SDEC, AIN(6), Yb, tid, wid, lane);
        float w[31];
#pragma unroll
        for (int j = 0; j < 31; ++j) w[j] = AIN(7)[j * 512 + tid];
        const float cb = AIN(8)[tid];
        for (int t = bid; t < MROWS / 16; t += G) conv_tile(lds, t, Hb, w, cb, AIN(9), AIN(10), Yb, tid, wid, lane);
    }
    GSYNC();
    {
        for (int l = 0; l < 2; ++l) {
            { pg8::Gemm gk = pg8::mk_gemm(Memn, Wk_t + (size_t)l * DM * DM, DM, DM, DM); pg8::Order Sk; Sk.init(4, 4, G, (bid + G - (32 * l) % G) % G);
              pg8::EpiStoreBf16 Ek{Kmat + (size_t)l * MEMROWS * DM, DM, 1.0f, nullptr}; pg8::gemm_phase(lds, gk, Sk, Ek, wid); }
            { pg8::Gemm gv = pg8::mk_gemm(Memn, Wv_t + (size_t)l * DM * DM, DM, DM, DM); pg8::Order Sv; Sv.init(4, 4, G, (bid + G - (32 * l + 16) % G) % G);
              pg8::EpiStoreBf16 Ev{Vmat + (size_t)l * MEMROWS * DM, DM, 1.0f, nullptr}; pg8::gemm_phase(lds, gv, Sv, Ev, wid); }
        }
    }
    if (bid >= 64 || G <= 64) {
        LAS float* scr = (LAS float*)(lds + wid * 16384);
        const int nwk = (G <= 64 ? G : G - 64) * 8, wk = (G <= 64 ? bid : bid - 64) * 8 + wid;
        for (int it = wk; it < NITEMS; it += nwk) weight_item(it, true, scr, lane);
        { const float* wq = AIN(16); const size_t n8 = (size_t)2 * DM * DM / 8;
          for (size_t i = (size_t)wk * 64 + lane; i < n8; i += (size_t)nwk * 64) { const f32x4 v0 = __builtin_nontemporal_load((const f32x4*)(wq + i * 8)), v1 = __builtin_nontemporal_load((const f32x4*)(wq + i * 8 + 4));
              u32x4 w; w.x = cvt_pk_bf16(v0[0], v0[1]); w.y = cvt_pk_bf16(v0[2], v0[3]); w.z = cvt_pk_bf16(v1[0], v1[1]); w.w = cvt_pk_bf16(v1[2], v1[3]);
              *(u32x4*)(Wq_n + i * 8) = w; } }
    }
    {
        const int e = bid * 512 + tid;
        for (int idx = e; idx < 16 * 16384; idx += G * 512) {
            const int bh = idx >> 14, rem = idx & 16383, reg = (rem >> 6) & 31, ln = rem & 63, dd = 16 * (reg >> 2) + 4 * (ln >> 4) + (reg & 3);
            float cur = 0.f;
            for (int sgi = 0; sgi < 16; ++sgi) { const int unit = bh * 16 + sgi; const float tmp = SLOC[(size_t)unit * 16384 + rem]; SST[(size_t)unit * 16384 + rem] = cur; cur = SDEC[unit * 128 + dd] * cur + tmp; }
        }
    }
    GSYNC();
    for (int l2 = 0; l2 < 2; ++l2) {
        { pg8::Gemm ga = pg8::mk_gemm(Kmat + (size_t)l2 * MEMROWS * DM, Wq_n + (size_t)l2 * DM * DM, DM, DM, 256);
          ga.a_sh = 2; ga.a_hi = (long)256 * DM; ga.a_mask = 3; ga.a_lo = 256; ga.b_mask = 3; ga.b_lo = 256;
          pg8::Order Sa; Sa.init(16, 4, G, (bid + G - (128 * l2) % G) % G);
          pg8::EpiStoreBf16 Ea{Abt + (size_t)l2 * 4096 * DM, DM, 0.0625f, nullptr}; pg8::gemm_phase(lds, ga, Sa, Ea, wid); }
        { pg8::Gemm gc = pg8::mk_gemm(Wo_t + (size_t)l2 * DM * DM, Vmat + (size_t)l2 * MEMROWS * DM, DM, DM, 256);
          gc.a_sh = 0; gc.a_hi = 0; gc.a_mask = 3; gc.a_lo = (long)256 * DM; gc.a_pn_off = 256; gc.b_pn_off = 256; gc.b_sh = 2; gc.b_hi = (long)256 * DM;
          pg8::Order Sc; Sc.init(16, 4, G, (bid + G - (128 * l2 + 64) % G) % G);
          pg8::EpiStoreBf16 Ec{Cbt + (size_t)l2 * 4096 * DM, DM, 1.0f, nullptr}; pg8::gemm_phase(lds, gc, Sc, Ec, wid); }
    }
    for (int u = bid; u < 256; u += G) hgrn_unit<true>(lds, u, Hb, LF, SST, SDEC, AIN(6), Yb, tid, wid, lane);
    GSYNC();
    {
        pg8::Gemm g = pg8::mk_gemm(Yb, Wout_t, DM, DM, DM); pg8::Order S; S.init(MROWS / 256, 4, G, bid);
        pg8::EpiStoreBf16 E{Ybuf, DM, 1.0f, nullptr}; pg8::gemm_phase(lds, g, S, E, wid);
    }
    GSYNC();
    ln_pass(x_in, nullptr, Ybuf, nullptr, Xb, AIN(14), AIN(15), MROWS, gw, NGW, lane);
    GSYNC();

    layer_body<0>(lds, xbar, wid, G, bid, gw, NGW);
    layer_body<1>(lds, xbar, wid, G, bid, gw, NGW);
}

#undef lane
#undef tid
#undef out
#undef x_in
extern "C" void kernel_launch(void* const* d_in, const int* in_sizes, int n_in, void* d_out, int out_size, void* d_ws, size_t ws_size, hipStream_t stream) {
    static int grid = 0;
    if (grid == 0) {
        if (n_in != 27 || out_size != MROWS * DM || ws_size < WS_END) { fprintf(stderr, "kernel_launch: unexpected problem (n_in %d, out %d, ws %zu)\n", n_in, out_size, ws_size); grid = -1; return; }
        int dev = 0, cus = 0, per_cu = 0;
        (void)hipGetDevice(&dev);
        (void)hipDeviceGetAttribute(&cus, hipDeviceAttributeMultiprocessorCount, dev);
        (void)hipFuncSetAttribute((const void*)fwd_megakernel, hipFuncAttributeMaxDynamicSharedMemorySize, LDS_BYTES);
        (void)hipOccupancyMaxActiveBlocksPerMultiprocessor(&per_cu, (const void*)fwd_megakernel, 512, LDS_BYTES);
        if (per_cu < 1) { fprintf(stderr, "kernel_launch: occupancy query reports %d blocks per CU\n", per_cu); }
        grid = cus;
    }
    if (grid < 0) return;
    if (hipMemsetAsync((char*)d_ws + WS_BAR, 0, XCD_BAR_WORDS * sizeof(unsigned), stream) != hipSuccess) { fprintf(stderr, "kernel_launch: hipMemsetAsync failed\n"); return; }
    Args a{};
    for (int i = 0; i < 27; ++i) a.in[i] = (const float*)d_in[i];
    a.out = (float*)d_out; a.ws = (unsigned char*)d_ws;
    void* args[] = {&a};
    hipError_t e = hipLaunchCooperativeKernel((const void*)fwd_megakernel, dim3(grid), dim3(512), args, LDS_BYTES, stream);
    if (e != hipSuccess) fprintf(stderr, "cooperative launch failed: %s (grid %d)\n", hipGetErrorString(e), grid);
}
```
